# Optimizing an MI355X kernel written in HIP

```python
import functools
import jax, jax.numpy as jnp
from jax import lax
import numpy as np

D_MODEL = 2048
BATCH = 4
SEQ = 4096
DEPTH = 1
DEC_BATCH = 128
DEC_SEQ = 8
PAST_LEN = 16384
PAGE_SIZE = 128

ATTN_HEADS = 16
ATTN_KV_HEADS = 4
ATTN_HEAD_DIM = 64
ATTN_GROUP = ATTN_HEADS // ATTN_KV_HEADS
WINDOW = 128
ATTN_WIDTH = ATTN_HEADS * ATTN_HEAD_DIM
KV_WIDTH = ATTN_KV_HEADS * ATTN_HEAD_DIM
HGRN_HEADS = 8
HGRN_DK = 128
HGRN_DV = 128
HGRN_KW = HGRN_HEADS * HGRN_DK
HGRN_VW = HGRN_HEADS * HGRN_DV
HGRN_CHUNK = 64
MIX_WIDTH = ATTN_WIDTH + HGRN_VW
IN_PROJ_WIDTH = ATTN_WIDTH + 2 * KV_WIDTH + 2 * HGRN_KW + 2 * HGRN_VW
IN_PROJ_SPLITS = (ATTN_WIDTH,
                  ATTN_WIDTH + KV_WIDTH,
                  ATTN_WIDTH + 2 * KV_WIDTH,
                  ATTN_WIDTH + 2 * KV_WIDTH + HGRN_KW,
                  ATTN_WIDTH + 2 * KV_WIDTH + 2 * HGRN_KW,
                  ATTN_WIDTH + 2 * KV_WIDTH + 2 * HGRN_KW + HGRN_VW)
MEM_TOKENS = 256
MEM_HEADS = 4
MEM_HEAD_DIM = 128
MEM_WIDTH = MEM_HEADS * MEM_HEAD_DIM
D_FF = 5632
FFN_RESIDUAL = 0.5
EPS = 1e-6

kernel_name = 'hymba_swa_sink_hgrn2_macaron_memxattn_step'


def rmsnorm(x, g):
    xf = x.astype(jnp.float32)
    y = xf * lax.rsqrt(jnp.mean(xf * xf, axis=-1, keepdims=True) + EPS)
    return (y * g.astype(jnp.float32)).astype(x.dtype)


def half_ffn(x, g_pre, g_post, w_gate, w_up, w_down):
    h = rmsnorm(x, g_pre)
    f = (jax.nn.silu(h @ w_gate) * (h @ w_up)) @ w_down
    return x + FFN_RESIDUAL * rmsnorm(f, g_post)


def alibi_slopes():
    return 2.0 ** (-8.0 * jnp.arange(1, ATTN_HEADS + 1, dtype=jnp.float32) / ATTN_HEADS)


def sink_attention(q, k, v, qpos, kpos, sinks):
    s = jnp.einsum('bnqhgd,bnkhd->bnhgqk', q, k).astype(jnp.float32) * (ATTN_HEAD_DIM ** -0.5)
    dist = qpos[:, :, None] - kpos[:, None, :]
    valid = (kpos[:, None, :] >= 0) & (dist >= 0) & (dist < WINDOW)
    slopes = alibi_slopes().reshape(ATTN_KV_HEADS, ATTN_GROUP)[:, :, None, None]
    s = s - slopes * dist[None, :, None, None].astype(jnp.float32)
    s = jnp.where(valid[None, :, None, None], s, -jnp.inf)
    sink = sinks.astype(jnp.float32).reshape(ATTN_KV_HEADS, ATTN_GROUP)[:, :, None, None]
    m = jnp.maximum(jnp.max(s, axis=-1, keepdims=True), sink)
    p = jnp.exp(s - m)
    p = p / (jnp.sum(p, axis=-1, keepdims=True) + jnp.exp(sink - m))
    return jnp.einsum('bnhgqk,bnkhd->bnqhgd', p.astype(v.dtype), v)


def window_attention_prompt(q, k, v, sinks):
    B, S = q.shape[:2]
    nb = S // WINDOW
    qb = q.reshape(B, nb, WINDOW, ATTN_KV_HEADS, ATTN_GROUP, ATTN_HEAD_DIM)
    kb = k.reshape(B, nb, WINDOW, ATTN_KV_HEADS, ATTN_HEAD_DIM)
    vb = v.reshape(B, nb, WINDOW, ATTN_KV_HEADS, ATTN_HEAD_DIM)

    def band(a):
        prev = jnp.concatenate([jnp.zeros_like(a[:, :1]), a[:, :-1]], axis=1)
        return jnp.concatenate([prev, a], axis=2)

    start = jnp.arange(nb)[:, None] * WINDOW
    qpos = start + jnp.arange(WINDOW)[None, :]
    kpos = start - WINDOW + jnp.arange(2 * WINDOW)[None, :]
    o = sink_attention(qb, band(kb), band(vb), qpos, kpos, sinks)
    return o.reshape(B, S, ATTN_WIDTH), k[:, -WINDOW:], v[:, -WINDOW:]


def window_attention_sample(q, k, v, sinks, cache_k, cache_v):
    B, T = q.shape[:2]
    kk = jnp.concatenate([cache_k, k], axis=1)
    vv = jnp.concatenate([cache_v, v], axis=1)
    qpos = (PAST_LEN + jnp.arange(T))[None, :]
    kpos = (PAST_LEN - WINDOW + jnp.arange(WINDOW + T))[None, :]
    o = sink_attention(q[:, None], kk[:, None], vv[:, None], qpos, kpos, sinks)
    return o.reshape(B, T, ATTN_WIDTH), kk[:, -WINDOW:], vv[:, -WINDOW:]


def hgrn2_features(q_raw, f_raw, i_raw, lower_bound):
    B, T = q_raw.shape[:2]
    shp = (B, T, HGRN_HEADS, HGRN_DK)
    fr = f_raw.astype(jnp.float32).reshape(shp)
    lb = lower_bound.reshape(HGRN_HEADS, HGRN_DK)
    logf = jnp.log(lb + (1.0 - lb) * jax.nn.sigmoid(fr))
    k = (1.0 - lb) * jax.nn.sigmoid(-fr)
    q = jax.nn.silu(q_raw.astype(jnp.float32)).reshape(shp)
    v = i_raw.astype(jnp.float32).reshape(B, T, HGRN_HEADS, HGRN_DV)
    return q, k, v, logf


def hgrn2_chunked(q, k, v, logf, S0, chunk):
    B, T = q.shape[:2]
    n = T // chunk

    def to_chunks(a):
        return jnp.moveaxis(a.reshape(B, n, chunk, *a.shape[2:]), 1, 0)

    causal = jnp.tril(jnp.ones((chunk, chunk), dtype=bool))[None, :, :, None, None]

    def step(S, inp):
        qc, kc, vc, lc = inp
        L = jnp.cumsum(lc, axis=1)
        diff = L[:, :, None] - L[:, None, :]
        decay = jnp.exp(jnp.where(causal, diff, -jnp.inf))
        A = jnp.einsum('bthk,btshk,bshk->bhts', qc, decay, kc)
        o = jnp.einsum('bhts,bshv->bthv', A, vc) + jnp.einsum('bthk,bhkv->bthv', qc * jnp.exp(L), S)
        L_end = L[:, -1]
        S_new = jnp.exp(L_end)[..., None] * S + jnp.einsum(
            'bshk,bshv->bhkv', kc * jnp.exp(L_end[:, None] - L), vc)
        return S_new, o

    S_fin, o = lax.scan(step, S0.astype(jnp.float32),
                        (to_chunks(q), to_chunks(k), to_chunks(v), to_chunks(logf)))
    o = jnp.moveaxis(o, 0, 1).reshape(B, T, HGRN_HEADS, HGRN_DV)
    return o, S_fin


def memory_kv(mem, g, w_k, w_v):
    B = mem.shape[0]
    m = rmsnorm(mem, g)
    k = (m @ w_k).reshape(B, -1, MEM_HEADS, MEM_HEAD_DIM)
    v = (m @ w_v).reshape(B, -1, MEM_HEADS, MEM_HEAD_DIM)
    return k, v


def memory_attention(h, mem_k, mem_v, w_q, w_o):
    B, T = h.shape[:2]
    q = (h @ w_q).reshape(B, T, MEM_HEADS, MEM_HEAD_DIM)
    s = jnp.einsum('bthd,bmhd->bhtm', q, mem_k).astype(jnp.float32) * (MEM_HEAD_DIM ** -0.5)
    p = jax.nn.softmax(s, axis=-1).astype(mem_v.dtype)
    o = jnp.einsum('bhtm,bmhd->bthd', p, mem_v).reshape(B, T, MEM_WIDTH)
    return o @ w_o


def trunk_layer(x, mem_k, mem_v, window_mixer, recurrent_mixer, p):
    x = half_ffn(x, p['ffn1_norm_pre'], p['ffn1_norm_post'], p['ffn1_w_gate'], p['ffn1_w_up'], p['ffn1_w_down'])
    B, T = x.shape[:2]
    h = rmsnorm(x, p['mix_norm_pre'])
    q_a, k_a, v_a, q_h, f_h, i_h, g_h = jnp.split(h @ p['w_in'], IN_PROJ_SPLITS, axis=-1)
    q_a = q_a.reshape(B, T, ATTN_KV_HEADS, ATTN_GROUP, ATTN_HEAD_DIM)
    k_a = k_a.reshape(B, T, ATTN_KV_HEADS, ATTN_HEAD_DIM)
    v_a = v_a.reshape(B, T, ATTN_KV_HEADS, ATTN_HEAD_DIM)
    o_a, win_k, win_v = window_mixer(q_a, k_a, v_a, p['attn_sinks'])
    hq, hk, hv, hlogf = hgrn2_features(q_h, f_h, i_h, p['lower_bound'])
    o_h, S = recurrent_mixer(hq, hk, hv, hlogf)
    a = rmsnorm(o_a, p['attn_out_gain'])
    r = rmsnorm(o_h.astype(x.dtype), p['hgrn_out_gain']).reshape(B, T, HGRN_VW) * jax.nn.silu(g_h)
    mixed = jnp.concatenate([a, r], axis=-1) @ p['w_out']
    x = x + rmsnorm(mixed, p['mix_norm_post'])
    h = rmsnorm(x, p['mem_norm_pre'])
    x = x + rmsnorm(memory_attention(h, mem_k, mem_v, p['w_mem_q'], p['w_mem_o']), p['mem_norm_post'])
    x = half_ffn(x, p['ffn2_norm_pre'], p['ffn2_norm_post'], p['ffn2_w_gate'], p['ffn2_w_up'], p['ffn2_w_down'])
    return x, win_k, win_v, S


def setup_inputs(seed: int = 0) -> dict:
    key = jax.random.key(seed)
    keys = iter(jax.random.split(key, 40))

    def nrm(shape, scale):
        return scale * jax.random.normal(next(keys), shape, jnp.float32)

    def gain(width):
        return 1.0 + 0.01 * nrm((DEPTH, width), 1.0)

    return {
        'x_prompt': nrm((BATCH, SEQ, D_MODEL), 1.0),
        'x_sample': nrm((DEC_BATCH, DEC_SEQ, D_MODEL), 1.0),
        'mem_prompt': nrm((BATCH, MEM_TOKENS, D_MODEL), 1.0),
        'cache_win_k': nrm((DEPTH, DEC_BATCH, WINDOW, ATTN_KV_HEADS, ATTN_HEAD_DIM), 1.0),
        'cache_win_v': nrm((DEPTH, DEC_BATCH, WINDOW, ATTN_KV_HEADS, ATTN_HEAD_DIM), 1.0),
        'state_hgrn': nrm((DEPTH, DEC_BATCH, HGRN_HEADS, HGRN_DK, HGRN_DV), 0.5),
        'cache_mem_k': nrm((DEPTH, DEC_BATCH, MEM_TOKENS, MEM_HEADS, MEM_HEAD_DIM), 1.0),
        'cache_mem_v': nrm((DEPTH, DEC_BATCH, MEM_TOKENS, MEM_HEADS, MEM_HEAD_DIM), 1.0),
        'ffn1_norm_pre': gain(D_MODEL),
        'ffn1_norm_post': gain(D_MODEL),
        'ffn1_w_gate': nrm((DEPTH, D_MODEL, D_FF), D_MODEL ** -0.5),
        'ffn1_w_up': nrm((DEPTH, D_MODEL, D_FF), D_MODEL ** -0.5),
        'ffn1_w_down': nrm((DEPTH, D_FF, D_MODEL), D_FF ** -0.5),
        'mix_norm_pre': gain(D_MODEL),
        'mix_norm_post': gain(D_MODEL),
        'w_in': nrm((DEPTH, D_MODEL, IN_PROJ_WIDTH), D_MODEL ** -0.5),
        'attn_sinks': nrm((DEPTH, ATTN_HEADS), 1.0),
        'hgrn_lb_logits': nrm((DEPTH + 1, HGRN_KW), 0.5),
        'attn_out_gain': gain(ATTN_WIDTH),
        'hgrn_out_gain': gain(HGRN_DV),
        'w_out': nrm((DEPTH, MIX_WIDTH, D_MODEL), MIX_WIDTH ** -0.5),
        'mem_norm_pre': gain(D_MODEL),
        'mem_norm_post': gain(D_MODEL),
        'mem_norm_kv': gain(D_MODEL),
        'w_mem_q': nrm((DEPTH, D_MODEL, MEM_WIDTH), D_MODEL ** -0.5),
        'w_mem_k': nrm((DEPTH, D_MODEL, MEM_WIDTH), D_MODEL ** -0.5),
        'w_mem_v': nrm((DEPTH, D_MODEL, MEM_WIDTH), D_MODEL ** -0.5),
        'w_mem_o': nrm((DEPTH, MEM_WIDTH, D_MODEL), MEM_WIDTH ** -0.5),
        'ffn2_norm_pre': gain(D_MODEL),
        'ffn2_norm_post': gain(D_MODEL),
        'ffn2_w_gate': nrm((DEPTH, D_MODEL, D_FF), D_MODEL ** -0.5),
        'ffn2_w_up': nrm((DEPTH, D_MODEL, D_FF), D_MODEL ** -0.5),
        'ffn2_w_down': nrm((DEPTH, D_FF, D_MODEL), D_FF ** -0.5),
    }


def reference(x_prompt, x_sample, mem_prompt, cache_win_k, cache_win_v, state_hgrn, cache_mem_k, cache_mem_v,
              ffn1_norm_pre, ffn1_norm_post, ffn1_w_gate, ffn1_w_up, ffn1_w_down,
              mix_norm_pre, mix_norm_post, w_in, attn_sinks, hgrn_lb_logits, attn_out_gain, hgrn_out_gain, w_out,
              mem_norm_pre, mem_norm_post, mem_norm_kv, w_mem_q, w_mem_k, w_mem_v, w_mem_o,
              ffn2_norm_pre, ffn2_norm_post, ffn2_w_gate, ffn2_w_up, ffn2_w_down):
    lower_bounds = jnp.cumsum(jax.nn.softmax(hgrn_lb_logits.astype(jnp.float32), axis=0), axis=0)
    y_p = x_prompt
    y_s = x_sample
    p_wk, p_wv, p_S, p_mk, p_mv, s_wk, s_wv, s_S = [], [], [], [], [], [], [], []
    for l in range(DEPTH):
        p = dict(ffn1_norm_pre=ffn1_norm_pre[l], ffn1_norm_post=ffn1_norm_post[l], ffn1_w_gate=ffn1_w_gate[l],
                 ffn1_w_up=ffn1_w_up[l], ffn1_w_down=ffn1_w_down[l],
                 mix_norm_pre=mix_norm_pre[l], mix_norm_post=mix_norm_post[l], w_in=w_in[l],
                 attn_sinks=attn_sinks[l], lower_bound=lower_bounds[l], attn_out_gain=attn_out_gain[l],
                 hgrn_out_gain=hgrn_out_gain[l], w_out=w_out[l],
                 mem_norm_pre=mem_norm_pre[l], mem_norm_post=mem_norm_post[l], w_mem_q=w_mem_q[l], w_mem_o=w_mem_o[l],
                 ffn2_norm_pre=ffn2_norm_pre[l], ffn2_norm_post=ffn2_norm_post[l], ffn2_w_gate=ffn2_w_gate[l],
                 ffn2_w_up=ffn2_w_up[l], ffn2_w_down=ffn2_w_down[l])
        mk, mv = memory_kv(mem_prompt, mem_norm_kv[l], w_mem_k[l], w_mem_v[l])
        S0_p = jnp.zeros((x_prompt.shape[0], HGRN_HEADS, HGRN_DK, HGRN_DV), jnp.float32)
        y_p, wk, wv, S = trunk_layer(y_p, mk, mv, window_attention_prompt,
                                     functools.partial(hgrn2_chunked, S0=S0_p, chunk=HGRN_CHUNK), p)
        p_wk.append(wk)
        p_wv.append(wv)
        p_S.append(S)
        p_mk.append(mk)
        p_mv.append(mv)
        y_s, wk, wv, S = trunk_layer(
            y_s, cache_mem_k[l], cache_mem_v[l],
            functools.partial(window_attention_sample, cache_k=cache_win_k[l], cache_v=cache_win_v[l]),
            functools.partial(hgrn2_chunked, S0=state_hgrn[l], chunk=x_sample.shape[1]), p)
        s_wk.append(wk)
        s_wv.append(wv)
        s_S.append(S)
    return (y_p, y_s, jnp.stack(p_wk), jnp.stack(p_wv), jnp.stack(p_S), jnp.stack(p_mk), jnp.stack(p_mv),
            jnp.stack(s_wk), jnp.stack(s_wv), jnp.stack(s_S))
```

```cpp
#include <hip/hip_runtime.h>
#include <hip/hip_cooperative_groups.h>
#include <cstdio>
#include <cstdint>
namespace cg = cooperative_groups;

#define LAS __attribute__((address_space(3)))
typedef unsigned short bf16;
typedef short bf16x8 __attribute__((ext_vector_type(8)));
typedef short s16x4 __attribute__((ext_vector_type(4)));
typedef float f32x4 __attribute__((ext_vector_type(4)));
typedef float f32x2 __attribute__((ext_vector_type(2)));
typedef unsigned u32x4 __attribute__((ext_vector_type(4)));
typedef unsigned u32x2 __attribute__((ext_vector_type(2)));
typedef __bf16 bf16x2_t __attribute__((ext_vector_type(2)));

constexpr int DM = 2048, DFF = 5632, NIN = 5632;
constexpr int MP = 16384, MS = 1024, MT = MP + MS;
constexpr int SEQ = 4096, PAST = 16384;
constexpr int ZQA = 0, ZKA = 1024, ZVA = 1280, ZHQ = 1536, ZHF = 2560, ZHI = 3584, ZHG = 4608;
constexpr float EPS = 1e-6f;
constexpr size_t O_Y = 0, O_PWK = 35651584, O_PWV = 35782656, O_PH = 35913728, O_PMK = 36438016, O_PMV = 36962304,
                 O_SWK = 37486592, O_SWV = 41680896, O_SH = 45875200;
constexpr size_t MiB = 1048576;
constexpr size_t WS_WGU = 0, WS_WD = 44 * MiB, WS_WIN = 66 * MiB, WS_WOUT = 88 * MiB, WS_WMQ = 96 * MiB, WS_WMKV = 98 * MiB, WS_WMO = 102 * MiB,
                 WS_MEMN = 104 * MiB, WS_MK = 108 * MiB, WS_MV = 109 * MiB, WS_DC = 110 * MiB, WS_HBUF = 112 * MiB, WS_ACT = 180 * MiB, WS_F = 367 * MiB,
                 WS_OI = 503 * MiB, WS_QH = 567 * MiB, WS_ST = 599 * MiB, WS_END = 663 * MiB;
constexpr size_t WS_BAR = 111 * MiB, WS_XB = 435 * MiB, WS_END2 = 663 * MiB;
constexpr size_t WS_QMEM = WS_OI, WS_OMEM = WS_OI + 17 * MiB;
constexpr int LDS_BYTES = 147456;

__device__ __forceinline__ unsigned pk2(float lo, float hi) { f32x2 v = {lo, hi}; bf16x2_t b = __builtin_convertvector(v, bf16x2_t); return __builtin_bit_cast(unsigned, b); }
__device__ __forceinline__ unsigned short f2bf(float f) { return (unsigned short)(pk2(f, 0.f) & 0xffffu); }
__device__ __forceinline__ float bf2f(unsigned short b) { return __uint_as_float(((unsigned)b) << 16); }
__device__ __forceinline__ float bflo(unsigned w) { return __uint_as_float(w << 16); }
__device__ __forceinline__ float bfhi(unsigned w) { return __uint_as_float(w & 0xffff0000u); }
__device__ __forceinline__ float wave_sum(float v) {
#pragma unroll
    for (int o = 1; o < 64; o <<= 1) v += __shfl_xor(v, o);
    return v;
}
__device__ __forceinline__ float sigmoidf_(float x) { return __builtin_amdgcn_rcpf(1.0f + __expf(-x)); }
__device__ __forceinline__ float siluf_(float x) { return x * sigmoidf_(x); }

#ifndef PHMASK_DEF
#define PHMASK_DEF 0xFFFFFFFFu
#endif
constexpr unsigned PHMASK = PHMASK_DEF;
namespace pg8 {
#define PG8_LAS __attribute__((address_space(3)))
typedef unsigned short bf16_t;
typedef short bf16x8 __attribute__((ext_vector_type(8)));
typedef float f32x4 __attribute__((ext_vector_type(4)));
typedef unsigned u32x4 __attribute__((ext_vector_type(4)));
constexpr int BM = 256, BK = 64, HALF = 128, HTB = HALF * BK * 2  , STAGE_BYTES = 8 * HTB, NXCD = 8, WGM = 8;

__host__ __device__ __forceinline__ int lds_byte(int r, int c) { const int st = (r >> 4) * 2 + (c >> 5), rr = r & 15, cc = c & 31, ob = rr * 64 + cc * 2; return st * 1024 + (ob ^ (((ob >> 9) & 1) << 5)); }
__host__ __device__ __forceinline__ void stage_rc(int b, int& R, int& C) { const int st = b / 1024, sb = b % 1024, swz = sb ^ (((sb >> 9) & 1) << 5); R = (st >> 1) * 16 + swz / 64; C = (st & 1) * 32 + (swz % 64) / 2; }
__host__ __device__ __forceinline__ int perm32(int rho) { const int n = rho >> 4, i = rho & 15; return 8 * (i >> 2) + 4 * n + (i & 3); }

struct Unit { int pm, pn, k0, nt, sp; };
struct Gemm { const bf16_t* A; const bf16_t* Bt; int M, N, K; };

struct StaticOrder {
    int nM, nN, nwg, G, c, ntf;
    __host__ __device__ void init(int M, int N, int G_, int c_, int K_) { nM = M / BM; nN = N / BM; nwg = nM * nN; G = G_; c = c_; ntf = K_ / BK; }
    __host__ __device__ __forceinline__ Unit get(int i) const {
        Unit u; u.pm = 0; u.pn = 0; u.k0 = 0; u.nt = 0; u.sp = -1;
        const long L = (long)i * G + c; if (L >= nwg) return u;
        int wgid = (int)L; { const int q = nwg / NXCD, r = nwg % NXCD, xcd = wgid % NXCD, off = wgid / NXCD; wgid = (xcd < r ? xcd * (q + 1) : r * (q + 1) + (xcd - r) * q) + off; }
        const int nig = WGM * nN, gid = wgid / nig, fm = gid * WGM, gsz = (nM - fm) < WGM ? (nM - fm) : WGM;
        u.pm = fm + ((wgid % nig) % gsz); u.pn = (wgid % nig) / gsz; u.nt = ntf; return u;
    }
    __device__ __forceinline__ void a_ready(const Unit&) const {}
    __device__ __forceinline__ void done(const Unit&) const {}
};

struct TailOrder {
    StaticOrder base; int rounds, ntf, cc;
    __host__ __device__ void init(int N, int G_, int c_, int K_) { base.init(16384, N, G_, c_, K_); rounds = base.nwg / G_; ntf = K_ / BK; cc = c_; }
    __host__ __device__ __forceinline__ Unit get(int i) const {
        if (i < rounds) return base.get(i);
        Unit u; u.pm = 0; u.pn = 0; u.k0 = 0; u.nt = 0; u.sp = -1;
        if (i > rounds) return u;
        const int tile = cc >> 3, s = cc & 7; u.pm = 64 + (tile >> 3); u.pn = tile & 7; u.sp = s;
        const int b8 = ntf / 8;
        if (b8 & 1) { u.nt = (s & 1) ? b8 - 1 : b8 + 1; u.k0 = (s >> 1) * (2 * b8) + (s & 1) * (b8 + 1); }
        else { u.nt = b8; u.k0 = s * b8; }
        return u;
    }
    __device__ __forceinline__ void a_ready(const Unit&) const {}
    __device__ __forceinline__ void done(const Unit&) const {}
};

struct EpiF32 {
    static constexpr bool PERM = false, AFTER_DRAIN = false;
    bf16_t* Cb; int ldc; float* part;
    __device__ __forceinline__ void operator()(const f32x4 (&acc)[2][2][4][2], const Unit& u, int wr, int wc, int fr, int fq) const {
        const int row0 = u.pm * BM + wr * 64 + fr, col0 = u.pn * BM + wc * 32 + 4 * fq;
        if (u.sp >= 0) { float* C = part + (size_t)u.sp * ((size_t)1024 * ldc);
#pragma unroll
            for (int ai = 0; ai < 2; ++ai)
#pragma unroll
                for (int m = 0; m < 4; ++m) { float* rowp = C + (size_t)(row0 - 16384 + ai * HALF + m * 16) * ldc + col0;
#pragma unroll
                    for (int bj = 0; bj < 2; ++bj)
#pragma unroll
                        for (int n = 0; n < 2; ++n) *(f32x4*)(rowp + bj * HALF + n * 16) = acc[ai][bj][m][n]; }
        } else {
#pragma unroll
            for (int ai = 0; ai < 2; ++ai)
#pragma unroll
                for (int m = 0; m < 4; ++m) { bf16_t* rowp = Cb + (size_t)(row0 + ai * HALF + m * 16) * ldc + col0;
#pragma unroll
                    for (int bj = 0; bj < 2; ++bj)
#pragma unroll
                        for (int n = 0; n < 2; ++n) { const f32x4 v = acc[ai][bj][m][n]; *(u32x2*)(rowp + bj * HALF + n * 16) = (u32x2){pk2(v[0], v[1]), pk2(v[2], v[3])}; } }
        }
    }
};
struct EpiBf16 {
    static constexpr bool PERM = true, AFTER_DRAIN = false;
    bf16_t* O; int ldc;
    __device__ __forceinline__ void operator()(const f32x4 (&acc)[2][2][4][2], const Unit& u, int wr, int wc, int fr, int fq) const {
        const int row0 = u.pm * BM + wr * 64 + fr, col0 = u.pn * BM + wc * 32 + 8 * fq;
#pragma unroll
        for (int ai = 0; ai < 2; ++ai)
#pragma unroll
            for (int m = 0; m < 4; ++m) { bf16_t* rowp = O + (size_t)(row0 + ai * HALF + m * 16) * ldc + col0;
#pragma unroll
                for (int bj = 0; bj < 2; ++bj) { const f32x4 v0 = acc[ai][bj][m][0], v1 = acc[ai][bj][m][1];
                    u32x4 w; w.x = pk2(v0[0], v0[1]); w.y = pk2(v0[2], v0[3]); w.z = pk2(v1[0], v1[1]); w.w = pk2(v1[2], v1[3]);
                    *(u32x4*)(rowp + bj * HALF) = w; } }
    }
};
struct EpiSwiglu {
    static constexpr bool PERM = true, AFTER_DRAIN = false;
    bf16_t* O; int ldc;
    __device__ __forceinline__ void operator()(const f32x4 (&acc)[2][2][4][2], const Unit& u, int wr, int wc, int fr, int fq) const {
        const int row0 = u.pm * BM + wr * 64 + fr, col0 = u.pn * HALF + wc * 32 + 8 * fq;
#pragma unroll
        for (int ai = 0; ai < 2; ++ai)
#pragma unroll
            for (int m = 0; m < 4; ++m) { bf16_t* rowp = O + (size_t)(row0 + ai * HALF + m * 16) * ldc + col0;
                float r[8];
#pragma unroll
                for (int n = 0; n < 2; ++n)
#pragma unroll
                    for (int j = 0; j < 4; ++j) { const float g = acc[ai][0][m][n][j], up = acc[ai][1][m][n][j]; r[n * 4 + j] = g * __builtin_amdgcn_rcpf(1.0f + __expf(-g)) * up; }
                u32x4 w; w.x = pk2(r[0], r[1]); w.y = pk2(r[2], r[3]); w.z = pk2(r[4], r[5]); w.w = pk2(r[6], r[7]);
                *(u32x4*)rowp = w; }
    }
};
struct EpiMemKV {
    static constexpr bool PERM = false, AFTER_DRAIN = false;
    float* outK; float* outV; bf16_t* bK; bf16_t* bV;
    __device__ __forceinline__ void operator()(const f32x4 (&acc)[2][2][4][2], const Unit& u, int wr, int wc, int fr, int fq) const {
        const int row0 = u.pm * BM + wr * 64 + fr; int colt = u.pn * BM; float* of = outK; bf16_t* ob = bK;
        if (colt >= 512) { colt -= 512; of = outV; ob = bV; }
        const int col0 = colt + wc * 32 + 4 * fq;
#pragma unroll
        for (int ai = 0; ai < 2; ++ai)
#pragma unroll
            for (int m = 0; m < 4; ++m) { const size_t off = (size_t)(row0 + ai * HALF + m * 16) * 512 + col0;
#pragma unroll
                for (int bj = 0; bj < 2; ++bj)
#pragma unroll
                    for (int n = 0; n < 2; ++n) { const f32x4 v = acc[ai][bj][m][n]; *(f32x4*)(of + off + bj * HALF + n * 16) = v;
                        u32x2 w; w.x = pk2(v[0], v[1]); w.y = pk2(v[2], v[3]); *(u32x2*)(ob + off + bj * HALF + n * 16) = w; } }
    }
};

template <class Epi, class Sched, bool ALIGN_EPI = false, bool SP2 = false>
__device__ __forceinline__ void gemm_phase(PG8_LAS unsigned char* lds, const Gemm g, const Sched& S, const Epi& E) {
    const int tid = threadIdx.x, wid = __builtin_amdgcn_readfirstlane(tid >> 6), lane = tid & 63, wr = wid >> 2, wc = wid & 3, fr = lane & 15, fq = lane >> 4;
    const int K = g.K;
    unsigned voffA[2], voffB[2];
#pragma unroll
    for (int i = 0; i < 2; ++i) { int R, C; stage_rc(tid * 16 + i * 8192, R, C); const int Rb = Epi::PERM ? ((R & ~31) + perm32(R & 31)) : R;
        voffA[i] = (unsigned)(R * K + C) * 2u; voffB[i] = (unsigned)(Rb * K + C) * 2u; }
    const size_t kstep = (size_t)(BK * 2);
    const size_t hstep = (size_t)HALF * K * 2;
    const size_t tstep = 2 * hstep;
    const unsigned ldsw = (unsigned)wid * 1024u;
    const int aoff = lds_byte(wr * 64 + fr, fq * 8), boff = lds_byte(wc * 32 + fr, fq * 8);
#define PG8_SA(b, h) (((b) * 2 + (h)) * HTB)
#define PG8_SB(b, h) ((4 + (b) * 2 + (h)) * HTB)
#define PG8_STAGE(bufoff, gbase, voff) do { _Pragma("unroll") for (int _i = 0; _i < 2; ++_i) \
        __builtin_amdgcn_global_load_lds((const unsigned*)((const char*)(gbase) + (voff)[_i]), (PG8_LAS unsigned*)(lds + (bufoff) + ldsw + _i * 8192), 16, 0, 0); } while (0)
#define PG8_LDA(dst, b, h) do { _Pragma("unroll") for (int m = 0; m < 4; ++m) _Pragma("unroll") for (int k = 0; k < 2; ++k) dst[m][k] = *(const PG8_LAS bf16x8*)(lds + PG8_SA(b, h) + aoff + m * 2048 + k * 1024); } while (0)
#define PG8_LDB(dst, b, h) do { _Pragma("unroll") for (int n = 0; n < 2; ++n) _Pragma("unroll") for (int k = 0; k < 2; ++k) dst[n][k] = *(const PG8_LAS bf16x8*)(lds + PG8_SB(b, h) + boff + n * 2048 + k * 1024); } while (0)
#define PG8_MMA(ai, bj, At, Bt) do { __builtin_amdgcn_s_setprio(1); _Pragma("unroll") for (int m = 0; m < 4; ++m) _Pragma("unroll") for (int n = 0; n < 2; ++n) _Pragma("unroll") for (int k = 0; k < 2; ++k) \
        acc[ai][bj][m][n] = __builtin_amdgcn_mfma_f32_16x16x32_bf16(Bt[n][k], At[m][k], acc[ai][bj][m][n], 0, 0, 0); __builtin_amdgcn_s_setprio(0); } while (0)
#define PG8_WAIT_V(n) asm volatile("s_waitcnt vmcnt(" #n ")" ::: "memory")
#define PG8_WAIT_L(n) asm volatile("s_waitcnt lgkmcnt(" #n ")" ::: "memory")
#define PG8_BAR __builtin_amdgcn_s_barrier()
#define PG8_SCHED __builtin_amdgcn_sched_barrier(0)
    Unit cur = S.get(0), nxt; int ui = 0;
    if (cur.nt == 0) return;
    f32x4 acc[2][2][4][2];
#pragma unroll
    for (int a = 0; a < 2; ++a)
#pragma unroll
        for (int b = 0; b < 2; ++b)
#pragma unroll
            for (int m = 0; m < 4; ++m)
#pragma unroll
                for (int n = 0; n < 2; ++n) acc[a][b][m][n] = (f32x4){0.f, 0.f, 0.f, 0.f};
    bf16x8 At[4][2], B0[2][2], B1[2][2];
    const char* cA = (const char*)g.A + (size_t)cur.pm * tstep + (size_t)cur.k0 * kstep; const char* cB = (const char*)g.Bt + (size_t)cur.pn * tstep + (size_t)cur.k0 * kstep;
    S.a_ready(cur);
    if constexpr (SP2) {
        PG8_STAGE(PG8_SB(0, 0), cB, voffB); PG8_STAGE(PG8_SB(0, 1), cB + hstep, voffB); PG8_STAGE(PG8_SA(0, 0), cA, voffA); PG8_STAGE(PG8_SA(0, 1), cA + hstep, voffA);
        if (wr == 1) PG8_BAR;
        PG8_WAIT_V(2); PG8_BAR;
        PG8_STAGE(PG8_SB(1, 0), cB + kstep, voffB); PG8_STAGE(PG8_SA(1, 0), cA + kstep, voffA); PG8_STAGE(PG8_SB(1, 1), cB + hstep + kstep, voffB);
        PG8_WAIT_V(6); PG8_BAR;
    } else {
        PG8_STAGE(PG8_SB(0, 0), cB, voffB); PG8_STAGE(PG8_SA(0, 0), cA, voffA); PG8_STAGE(PG8_SB(0, 1), cB + hstep, voffB); PG8_STAGE(PG8_SA(0, 1), cA + hstep, voffA);
        if (wr == 1) PG8_BAR;
        PG8_WAIT_V(4); PG8_BAR;
        PG8_STAGE(PG8_SB(1, 0), cB + kstep, voffB); PG8_STAGE(PG8_SA(1, 0), cA + kstep, voffA); PG8_STAGE(PG8_SB(1, 1), cB + hstep + kstep, voffB);
        PG8_WAIT_V(6); PG8_BAR;
    }
    for (;;) {
        nxt = S.get(ui + 1); const bool has_next = nxt.nt != 0;
        const char* nA = has_next ? (const char*)g.A + (size_t)nxt.pm * tstep + (size_t)nxt.k0 * kstep : cA; const char* nB = has_next ? (const char*)g.Bt + (size_t)nxt.pn * tstep + (size_t)nxt.k0 * kstep : cB;
        const int nt = cur.nt;
        for (int t = 0; t < nt; t += 2) {
            const bool last = (t == nt - 2);
            const char* a1 = cA + (size_t)(t + 1) * kstep;
            const char* a2 = last ? nA : cA + (size_t)(t + 2) * kstep; const char* b2 = last ? nB : cB + (size_t)(t + 2) * kstep;
            const char* a3 = a2 + kstep; const char* b3 = b2 + kstep;
            if (last && has_next) S.a_ready(nxt);
            if constexpr (SP2) {
            PG8_LDB(B0, 0, 0); PG8_LDB(B1, 0, 1); PG8_SCHED; PG8_LDA(At, 0, 0); PG8_STAGE(PG8_SA(1, 1), a1 + hstep, voffA);
            PG8_WAIT_V(8); PG8_WAIT_L(0); PG8_BAR; PG8_MMA(0, 0, At, B0); PG8_MMA(0, 1, At, B1); PG8_BAR; PG8_SCHED;
            PG8_LDA(At, 0, 1); PG8_STAGE(PG8_SB(0, 0), b2, voffB); PG8_STAGE(PG8_SB(0, 1), b2 + hstep, voffB); PG8_STAGE(PG8_SA(0, 0), a2, voffA);
            PG8_WAIT_V(8); PG8_WAIT_L(0); PG8_BAR; PG8_MMA(1, 0, At, B0); PG8_MMA(1, 1, At, B1); PG8_BAR; PG8_SCHED;
            PG8_LDB(B0, 1, 0); PG8_LDB(B1, 1, 1); PG8_SCHED; PG8_LDA(At, 1, 0); PG8_STAGE(PG8_SA(0, 1), a2 + hstep, voffA);
            PG8_WAIT_V(8); PG8_WAIT_L(0); PG8_BAR; PG8_MMA(0, 0, At, B0); PG8_MMA(0, 1, At, B1); PG8_BAR; PG8_SCHED;
            PG8_LDA(At, 1, 1); PG8_STAGE(PG8_SB(1, 0), b3, voffB); PG8_STAGE(PG8_SB(1, 1), b3 + hstep, voffB); PG8_STAGE(PG8_SA(1, 0), a3, voffA);
            PG8_WAIT_V(8); PG8_WAIT_L(0); PG8_BAR; PG8_MMA(1, 0, At, B0); PG8_MMA(1, 1, At, B1); PG8_BAR; PG8_SCHED;
            } else {
            PG8_LDB(B0, 0, 0); PG8_SCHED; PG8_LDA(At, 0, 0); PG8_STAGE(PG8_SA(1, 1), a1 + hstep, voffA);
            PG8_WAIT_L(8); PG8_BAR; PG8_WAIT_L(0); PG8_MMA(0, 0, At, B0); PG8_BAR; PG8_SCHED;
            PG8_LDB(B1, 0, 1); PG8_STAGE(PG8_SB(0, 0), b2, voffB);
            PG8_BAR; PG8_WAIT_L(0); PG8_MMA(0, 1, At, B1); PG8_BAR;
            PG8_LDA(At, 0, 1); PG8_STAGE(PG8_SA(0, 0), a2, voffA);
            PG8_BAR; PG8_WAIT_L(0); PG8_MMA(1, 0, At, B0); PG8_BAR; PG8_SCHED;
            PG8_STAGE(PG8_SB(0, 1), b2 + hstep, voffB);
            PG8_WAIT_V(6); PG8_BAR; PG8_MMA(1, 1, At, B1); PG8_BAR;
            PG8_LDB(B0, 1, 0); PG8_SCHED; PG8_LDA(At, 1, 0); PG8_STAGE(PG8_SA(0, 1), a2 + hstep, voffA);
            PG8_WAIT_L(8); PG8_BAR; PG8_WAIT_L(0); PG8_MMA(0, 0, At, B0); PG8_BAR; PG8_SCHED;
            PG8_LDB(B1, 1, 1); PG8_STAGE(PG8_SB(1, 0), b3, voffB);
            PG8_BAR; PG8_WAIT_L(0); PG8_MMA(0, 1, At, B1); PG8_BAR;
            PG8_LDA(At, 1, 1); PG8_STAGE(PG8_SA(1, 0), a3, voffA);
            PG8_BAR; PG8_WAIT_L(0); PG8_MMA(1, 0, At, B0); PG8_BAR; PG8_SCHED;
            PG8_STAGE(PG8_SB(1, 1), b3 + hstep, voffB);
            PG8_WAIT_V(6); PG8_BAR; PG8_MMA(1, 1, At, B1); PG8_BAR;
            }
        }
        if constexpr (ALIGN_EPI) { if (wr == 0) PG8_BAR; }
        if constexpr (!Epi::AFTER_DRAIN) { E(acc, cur, wr, wc, fr, fq); S.done(cur); }
        if (!has_next) break;
#pragma unroll
        for (int a = 0; a < 2; ++a)
#pragma unroll
            for (int b = 0; b < 2; ++b)
#pragma unroll
                for (int m = 0; m < 4; ++m)
#pragma unroll
                    for (int n = 0; n < 2; ++n) acc[a][b][m][n] = (f32x4){0.f, 0.f, 0.f, 0.f};
        cur = nxt; cA = nA; cB = nB; ++ui;
        if constexpr (ALIGN_EPI) { if (wr == 1) PG8_BAR; }
    }
    PG8_WAIT_V(0);
    if constexpr (!ALIGN_EPI) { if (wr == 0) PG8_BAR; }
    PG8_BAR;
    if constexpr (Epi::AFTER_DRAIN) { E.fused(acc, cur, wr, wc, fr, fq, lds, wid, lane); S.done(cur); }
#undef PG8_SA
#undef PG8_SB
#undef PG8_STAGE
#undef PG8_LDA
#undef PG8_LDB
#undef PG8_MMA
#undef PG8_WAIT_V
#undef PG8_WAIT_L
#undef PG8_BAR
#undef PG8_SCHED
}
}

struct Params { const float* in[33]; float* out; unsigned char* ws; };

__device__ __forceinline__ void wt_load(f32x4 (&r)[8], const float* W, int N, int nblk, int item, int nitems, int lane) {
    if (item < nitems) { const int kb = item / nblk, nb = item % nblk; const float* src = W + (size_t)(64 * kb + (lane >> 3)) * N + 32 * nb + (lane & 7) * 4;
#pragma unroll
        for (int i = 0; i < 8; ++i) r[i] = *(const f32x4*)(src + (size_t)(8 * i) * N); }
}
__device__ __forceinline__ void wt_store(const f32x4 (&r)[8], int K, int nblk, bf16* WT, int mode, int row_off, LAS float* scr, int item, int nitems, int lane) {
    if (item < nitems) {
        const int kb = item / nblk, nb = item % nblk, k0 = 64 * kb, n0 = 32 * nb;
#pragma unroll
        for (int i = 0; i < 8; ++i) { LAS float* d = scr + (8 * i + (lane >> 3)) * 33 + (lane & 7) * 4; d[0] = r[i][0]; d[1] = r[i][1]; d[2] = r[i][2]; d[3] = r[i][3]; }
        asm volatile("s_waitcnt lgkmcnt(0)" ::: "memory");
        const int c = lane & 7;
#pragma unroll
        for (int j = 0; j < 4; ++j) { const int n = (lane >> 3) + 8 * j; const LAS float* s = scr + (8 * c) * 33 + n;
            u32x4 o; o.x = pk2(s[0 * 33], s[1 * 33]); o.y = pk2(s[2 * 33], s[3 * 33]); o.z = pk2(s[4 * 33], s[5 * 33]); o.w = pk2(s[6 * 33], s[7 * 33]);
            const int ng = n0 + n; int drow;
            if (mode == 0) drow = row_off + ng; else drow = (ng >> 7) * 256 + (mode == 2 ? 128 : 0) + (ng & 127);
            *(u32x4*)(WT + (size_t)drow * K + k0 + 8 * c) = o; }
        asm volatile("s_waitcnt lgkmcnt(0)" ::: "memory");
    }
}
__device__ __forceinline__ void wt_matrix(const float* W, int K, int N, bf16* WT, int mode, int row_off, LAS float* scr, int gw, int NGW, int lane) {
    const int nblk = N / 32, nitems = (K / 64) * nblk;
    f32x4 ra[8], rb[8], rc[8];
#pragma unroll
    for (int i = 0; i < 8; ++i) { ra[i] = (f32x4){0.f, 0.f, 0.f, 0.f}; rb[i] = ra[i]; rc[i] = ra[i]; }
    int item = gw;
    wt_load(ra, W, N, nblk, item, nitems, lane); wt_load(rb, W, N, nblk, item + NGW, nitems, lane);
    while (item < nitems) {
        wt_load(rc, W, N, nblk, item + 2 * NGW, nitems, lane); wt_store(ra, K, nblk, WT, mode, row_off, scr, item, nitems, lane);
        wt_load(ra, W, N, nblk, item + 3 * NGW, nitems, lane); wt_store(rb, K, nblk, WT, mode, row_off, scr, item + NGW, nitems, lane);
        wt_load(rb, W, N, nblk, item + 4 * NGW, nitems, lane); wt_store(rc, K, nblk, WT, mode, row_off, scr, item + 2 * NGW, nitems, lane);
        item += 3 * NGW;
    }
}

template <int XSRC>
__device__ __forceinline__ void nr_load_x(u32x4 (&raw)[8], const float* xa, const float* xb, int split, const bf16* xbf, int row, int lane) {
    if (XSRC == 0) { const float* xr = row < split ? xa + (size_t)row * DM : xb + (size_t)(row - split) * DM;
#pragma unroll
        for (int j = 0; j < 4; ++j) { raw[2 * j] = *(const u32x4*)(xr + j * 512 + lane * 8); raw[2 * j + 1] = *(const u32x4*)(xr + j * 512 + lane * 8 + 4); } }
    else {
#pragma unroll
        for (int j = 0; j < 4; ++j) raw[j] = *(const u32x4*)(xbf + (size_t)row * DM + j * 512 + lane * 8); }
}
__device__ __forceinline__ void nr_unpack(const u32x4 w, f32x4& a, f32x4& b) { a = (f32x4){bflo(w.x), bfhi(w.x), bflo(w.y), bfhi(w.y)}; b = (f32x4){bflo(w.z), bfhi(w.z), bflo(w.w), bfhi(w.w)}; }
template <int XSRC, bool HAS_F, bool HAS_NEXT, bool SPLIT, int XDST  >
__device__ __forceinline__ void norm_rows(const bf16* Fm, const float* part, const float* xa, const float* xb, int split, int nrows, const bf16* xin_bf, bf16* xout_bf, float* xout_f,
                                          float scale, const float* g_post, const float* g_next, bf16* hout, LAS unsigned char* lds, int tid, int gw, int NGW, int lane) {
    LAS float* gl = (LAS float*)lds;
    __syncthreads();
    { const int i = tid; if (HAS_F) *(LAS f32x4*)(gl + i * 4) = *(const f32x4*)(g_post + i * 4); if (HAS_NEXT) *(LAS f32x4*)(gl + 2048 + i * 4) = *(const f32x4*)(g_next + i * 4); }
    __syncthreads();
    int row = gw;
    u32x4 xr[8], fr_[4];
#pragma unroll
    for (int i = 0; i < 8; ++i) xr[i] = (u32x4){0u, 0u, 0u, 0u};
#pragma unroll
    for (int j = 0; j < 4; ++j) fr_[j] = (u32x4){0u, 0u, 0u, 0u};
    if (row < nrows) { nr_load_x<XSRC>(xr, xa, xb, split, xin_bf, row, lane);
        if (HAS_F && !(SPLIT && row >= MP)) {
#pragma unroll
            for (int j = 0; j < 4; ++j) fr_[j] = *(const u32x4*)(Fm + (size_t)row * DM + j * 512 + lane * 8); } }
    while (row < nrows) {
        const int nrow = row + NGW;
        u32x4 xn[8], fn[4];
#pragma unroll
        for (int i = 0; i < 8; ++i) xn[i] = (u32x4){0u, 0u, 0u, 0u};
#pragma unroll
        for (int j = 0; j < 4; ++j) fn[j] = (u32x4){0u, 0u, 0u, 0u};
        if (nrow < nrows) { nr_load_x<XSRC>(xn, xa, xb, split, xin_bf, nrow, lane);
            if (HAS_F && !(SPLIT && nrow >= MP)) {
#pragma unroll
                for (int j = 0; j < 4; ++j) fn[j] = *(const u32x4*)(Fm + (size_t)nrow * DM + j * 512 + lane * 8); } }
        f32x4 x[8];
        if (XSRC == 0) {
#pragma unroll
            for (int i = 0; i < 8; ++i) x[i] = __builtin_bit_cast(f32x4, xr[i]); }
        else {
#pragma unroll
            for (int j = 0; j < 4; ++j) nr_unpack(xr[j], x[2 * j], x[2 * j + 1]); }
        if (HAS_F) {
            f32x4 f[8];
            if (SPLIT && row >= MP) {
#pragma unroll
                for (int i = 0; i < 8; ++i) { const float* pr = part + (size_t)(row - MP) * DM + (i >> 1) * 512 + lane * 8 + (i & 1) * 4; f32x4 a = *(const f32x4*)pr;
#pragma unroll
                    for (int s = 1; s < 8; ++s) a = a + *(const f32x4*)(pr + (size_t)s * 1024 * DM);
                    f[i] = a; __builtin_amdgcn_sched_barrier(0); } }
            else {
#pragma unroll
                for (int j = 0; j < 4; ++j) nr_unpack(fr_[j], f[2 * j], f[2 * j + 1]); }
            float ss = 0.f;
#pragma unroll
            for (int i = 0; i < 8; ++i) ss += (f[i][0] * f[i][0] + f[i][1] * f[i][1]) + (f[i][2] * f[i][2] + f[i][3] * f[i][3]);
            const float rstd = rsqrtf(wave_sum(ss) * (1.0f / DM) + EPS) * scale;
#pragma unroll
            for (int i = 0; i < 8; ++i) { const f32x4 g = *(const LAS f32x4*)(gl + (i >> 1) * 512 + lane * 8 + (i & 1) * 4); x[i] = x[i] + f[i] * g * rstd; }
            if (XDST == 1) {
#pragma unroll
                for (int j = 0; j < 4; ++j) *(u32x4*)(xout_bf + (size_t)row * DM + j * 512 + lane * 8) = (u32x4){pk2(x[2 * j][0], x[2 * j][1]), pk2(x[2 * j][2], x[2 * j][3]), pk2(x[2 * j + 1][0], x[2 * j + 1][1]), pk2(x[2 * j + 1][2], x[2 * j + 1][3])}; }
            if (XDST == 2) {
#pragma unroll
                for (int i = 0; i < 8; ++i) *(f32x4*)(xout_f + (size_t)row * DM + (i >> 1) * 512 + lane * 8 + (i & 1) * 4) = x[i]; }
        }
        if (HAS_NEXT) {
            float ss = 0.f;
#pragma unroll
            for (int i = 0; i < 8; ++i) ss += (x[i][0] * x[i][0] + x[i][1] * x[i][1]) + (x[i][2] * x[i][2] + x[i][3] * x[i][3]);
            const float rstd = rsqrtf(wave_sum(ss) * (1.0f / DM) + EPS);
            f32x4 h[8];
#pragma unroll
            for (int i = 0; i < 8; ++i) { const f32x4 g = *(const LAS f32x4*)(gl + 2048 + (i >> 1) * 512 + lane * 8 + (i & 1) * 4); h[i] = x[i] * g * rstd; }
#pragma unroll
            for (int j = 0; j < 4; ++j) *(u32x4*)(hout + (size_t)row * DM + j * 512 + lane * 8) = (u32x4){pk2(h[2 * j][0], h[2 * j][1]), pk2(h[2 * j][2], h[2 * j][3]), pk2(h[2 * j + 1][0], h[2 * j + 1][1]), pk2(h[2 * j + 1][2], h[2 * j + 1][3])};
        }
#pragma unroll
        for (int i = 0; i < 8; ++i) xr[i] = xn[i];
#pragma unroll
        for (int j = 0; j < 4; ++j) fr_[j] = fn[j];
        row = nrow;
    }
    __syncthreads();
}

#define LDS_BARRIER() do { asm volatile("s_waitcnt lgkmcnt(0)" ::: "memory"); __builtin_amdgcn_s_barrier(); asm volatile("" ::: "memory"); } while (0)
#define MFMA16(a, b, c) __builtin_amdgcn_mfma_f32_16x16x32_bf16((a), (b), (c), 0, 0, 0)
__device__ __forceinline__ u32x4 ld8_bf16(const bf16* p) { return *(const u32x4*)p; }
__device__ __forceinline__ u32x4 ld8_f32(const float* p) { const f32x4 a = *(const f32x4*)p, b = *(const f32x4*)(p + 4); u32x4 w; w.x = pk2(a[0], a[1]); w.y = pk2(a[2], a[3]); w.z = pk2(b[0], b[1]); w.w = pk2(b[2], b[3]); return w; }
__device__ __forceinline__ void put_k(LAS unsigned char* Kl, int kstr, int kl, int dc, u32x4 v) { *(LAS u32x4*)(Kl + kl * kstr + dc * 16) = v; }
__device__ __forceinline__ void put_vt(LAS unsigned char* Vl, int vstr, int kl, int dc, u32x4 v) {
    LAS unsigned short* b = (LAS unsigned short*)(Vl + (dc * 8) * vstr + kl * 2); const int s2 = vstr / 2;
    b[0] = (unsigned short)(v.x & 0xffff); b[s2] = (unsigned short)(v.x >> 16); b[2 * s2] = (unsigned short)(v.y & 0xffff); b[3 * s2] = (unsigned short)(v.y >> 16);
    b[4 * s2] = (unsigned short)(v.z & 0xffff); b[5 * s2] = (unsigned short)(v.z >> 16); b[6 * s2] = (unsigned short)(v.w & 0xffff); b[7 * s2] = (unsigned short)(v.w >> 16);
}
template <int D, int NKT, bool WIN>
__device__ __forceinline__ void attn_group(const LAS unsigned char* Kl, int kstr, const LAS unsigned char* Vl, int vstr, const bf16x8 (&qf)[D / 32],
                                           int qpos, int kbase, float slope, float sink, float scale, int fr, int fq, f32x4 (&o)[D / 16]) {
    f32x4 s[NKT];
#pragma unroll
    for (int kt = 0; kt < NKT; ++kt) { s[kt] = (f32x4){0.f, 0.f, 0.f, 0.f};
#pragma unroll
        for (int ks = 0; ks < D / 32; ++ks) { const bf16x8 a = *(const LAS bf16x8*)(Kl + (kt * 16 + fr) * kstr + (ks * 32 + fq * 8) * 2); s[kt] = MFMA16(a, qf[ks], s[kt]); }
        if ((kt & (D == 64 ? 3 : 1)) == (D == 64 ? 3 : 1)) __builtin_amdgcn_sched_barrier(0); }
    float m = -1e30f;
#pragma unroll
    for (int kt = 0; kt < NKT; ++kt)
#pragma unroll
        for (int j = 0; j < 4; ++j) { float v = s[kt][j] * scale;
            if (WIN) { const int kpos = kbase + kt * 16 + fq * 4 + j, dist = qpos - kpos; const bool valid = (kpos >= 0) && (dist >= 0) && (dist < 128); v = valid ? v - slope * (float)dist : -1e30f; }
            s[kt][j] = v; m = fmaxf(m, v); }
    m = fmaxf(m, __shfl_xor(m, 16)); m = fmaxf(m, __shfl_xor(m, 32));
    if (WIN) m = fmaxf(m, sink);
    float sum = 0.f;
#pragma unroll
    for (int kt = 0; kt < NKT; ++kt)
#pragma unroll
        for (int j = 0; j < 4; ++j) { const float pe = __expf(s[kt][j] - m); s[kt][j] = pe; sum += pe; }
    sum += __shfl_xor(sum, 16); sum += __shfl_xor(sum, 32);
    if (WIN) sum += __expf(sink - m);
    const float inv = 1.0f / sum;
#pragma unroll
    for (int dt = 0; dt < D / 16; ++dt) o[dt] = (f32x4){0.f, 0.f, 0.f, 0.f};
#pragma unroll
    for (int kk = 0; kk < NKT / 2; ++kk) {
        u32x4 pw; pw.x = pk2(s[2 * kk][0], s[2 * kk][1]); pw.y = pk2(s[2 * kk][2], s[2 * kk][3]); pw.z = pk2(s[2 * kk + 1][0], s[2 * kk + 1][1]); pw.w = pk2(s[2 * kk + 1][2], s[2 * kk + 1][3]);
        const bf16x8 pf = __builtin_bit_cast(bf16x8, pw);
#pragma unroll
        for (int dt = 0; dt < D / 16; ++dt) {
            const u32x2 lo = *(const LAS u32x2*)(Vl + (dt * 16 + fr) * vstr + ((2 * kk) * 16 + fq * 4) * 2), hi = *(const LAS u32x2*)(Vl + (dt * 16 + fr) * vstr + ((2 * kk + 1) * 16 + fq * 4) * 2);
            u32x4 aw; aw.x = lo.x; aw.y = lo.y; aw.z = hi.x; aw.w = hi.y;
            o[dt] = MFMA16(__builtin_bit_cast(bf16x8, aw), pf, o[dt]); }
        __builtin_amdgcn_sched_barrier(0);
    }
#pragma unroll
    for (int dt = 0; dt < D / 16; ++dt) o[dt] = o[dt] * inv;
}

__device__ __forceinline__ void win_attn_prompt_unit(int unit, const bf16* Z, bf16* HB, const float* sinks, LAS unsigned char* lds, int tid, int wave, int lane) {
    constexpr int KSTR = 144, VSTR = 520; LAS unsigned char* Kl = lds; LAS unsigned char* Vl = lds + 256 * KSTR;
    const int kvh = unit & 3, n = (unit >> 2) & 31, b = unit >> 7; const int fr = lane & 15, fq = lane >> 4;
    const int pos0 = n * 128 - 128;
#pragma unroll
    for (int idx = tid; idx < 256 * 8; idx += 512) { const int kl = idx >> 3, dc = idx & 7; const int pos = pos0 + kl;
        u32x4 kv = (u32x4){0u, 0u, 0u, 0u}, vv = kv;
        if (pos >= 0) { const bf16* zr = Z + (size_t)(b * SEQ + pos) * NIN + kvh * 64 + dc * 8; kv = ld8_bf16(zr + ZKA); vv = ld8_bf16(zr + ZVA); }
        put_k(Kl, KSTR, kl, dc, kv); put_vt(Vl, VSTR, kl, dc, vv); }
    LDS_BARRIER();
    const int g = wave >> 1, hq = kvh * 4 + g; const float slope = exp2f(-0.5f * (float)(hq + 1)), sink = sinks[hq];
    bf16x8 qn[2];
#pragma unroll
    for (int ks = 0; ks < 2; ++ks) qn[ks] = __builtin_bit_cast(bf16x8, ld8_bf16(Z + ((size_t)b * SEQ + n * 128 + ((wave & 1) * 4) * 16 + fr) * NIN + ZQA + hq * 64 + ks * 32 + fq * 8));
#pragma unroll 1
    for (int i = 0; i < 4; ++i) { const int tl = ((wave & 1) * 4 + i) * 16 + fr; const size_t row = (size_t)b * SEQ + n * 128 + tl;
        bf16x8 qf[2]; qf[0] = qn[0]; qf[1] = qn[1];
        if (i < 3) {
#pragma unroll
            for (int ks = 0; ks < 2; ++ks) qn[ks] = __builtin_bit_cast(bf16x8, ld8_bf16(Z + (row + 16) * NIN + ZQA + hq * 64 + ks * 32 + fq * 8)); }
        f32x4 o[4];
        attn_group<64, 16, true>(Kl, KSTR, Vl, VSTR, qf, n * 128 + tl, pos0, slope, sink, 0.125f, fr, fq, o);
#pragma unroll
        for (int dt = 0; dt < 4; ++dt) { u32x2 w; w.x = pk2(o[dt][0], o[dt][1]); w.y = pk2(o[dt][2], o[dt][3]); *(u32x2*)(HB + row * DM + hq * 64 + dt * 16 + fq * 4) = w; } }
    LDS_BARRIER();
}
__device__ __forceinline__ void win_attn_sample_unit(int unit, const bf16* Z, const float* cK, const float* cV, bf16* HB, const float* sinks, LAS unsigned char* lds, int tid, int wave, int lane) {
    constexpr int KSTR = 144, VSTR = 520; LAS unsigned char* Kl = lds; LAS unsigned char* Vl = lds + 256 * KSTR;
    const int kvh = unit & 3, b = unit >> 2; const int fr = lane & 15, fq = lane >> 4;
#pragma unroll
    for (int idx = tid; idx < 160 * 8; idx += 512) { const int kl = idx >> 3, dc = idx & 7;
        u32x4 kv = (u32x4){0u, 0u, 0u, 0u}, vv = kv;
        if (kl < 128) { const size_t off = ((size_t)(b * 128 + kl) * 4 + kvh) * 64 + dc * 8; kv = ld8_f32(cK + off); vv = ld8_f32(cV + off); }
        else if (kl < 136) { const bf16* zr = Z + (size_t)(MP + b * 8 + (kl - 128)) * NIN + kvh * 64 + dc * 8; kv = ld8_bf16(zr + ZKA); vv = ld8_bf16(zr + ZVA); }
        put_k(Kl, KSTR, kl, dc, kv); put_vt(Vl, VSTR, kl, dc, vv); }
    LDS_BARRIER();
    if (wave < 2) { const int g = wave * 2 + (fr >> 3), hq = kvh * 4 + g, ti = fr & 7; const float slope = exp2f(-0.5f * (float)(hq + 1)), sink = sinks[hq];
        const size_t row = (size_t)MP + b * 8 + ti;
        bf16x8 qf[2];
#pragma unroll
        for (int ks = 0; ks < 2; ++ks) qf[ks] = __builtin_bit_cast(bf16x8, ld8_bf16(Z + row * NIN + ZQA + hq * 64 + ks * 32 + fq * 8));
        f32x4 o[4];
        attn_group<64, 10, true>(Kl, KSTR, Vl, VSTR, qf, PAST + ti, PAST - 128, slope, sink, 0.125f, fr, fq, o);
#pragma unroll
        for (int dt = 0; dt < 4; ++dt) { u32x2 w; w.x = pk2(o[dt][0], o[dt][1]); w.y = pk2(o[dt][2], o[dt][3]); *(u32x2*)(HB + row * DM + hq * 64 + dt * 16 + fq * 4) = w; } }
    LDS_BARRIER();
}
__device__ __forceinline__ void mem_attn_prompt_unit(int unit, const bf16* QM, const bf16* MK, const bf16* MV, bf16* OM, LAS unsigned char* lds, int tid, int wave, int lane) {
    constexpr int KSTR = 272, VSTR = 520; LAS unsigned char* Kl = lds; LAS unsigned char* Vl = lds + 256 * KSTR;
    const int qb = unit & 15, h = (unit >> 4) & 3, b = unit >> 6; const int fr = lane & 15, fq = lane >> 4;
#pragma unroll
    for (int idx = tid; idx < 256 * 16; idx += 512) { const int kl = idx >> 4, dc = idx & 15; const size_t off = (size_t)(b * 256 + kl) * 512 + h * 128 + dc * 8;
        put_k(Kl, KSTR, kl, dc, ld8_bf16(MK + off)); put_vt(Vl, VSTR, kl, dc, ld8_bf16(MV + off)); }
    LDS_BARRIER();
    bf16x8 qn[4];
#pragma unroll
    for (int ks = 0; ks < 4; ++ks) qn[ks] = __builtin_bit_cast(bf16x8, ld8_bf16(QM + ((size_t)b * SEQ + qb * 256 + (wave * 2) * 16 + fr) * 512 + h * 128 + ks * 32 + fq * 8));
#pragma unroll 1
    for (int i = 0; i < 2; ++i) { const size_t row = (size_t)b * SEQ + qb * 256 + (wave * 2 + i) * 16 + fr;
        bf16x8 qf[4];
#pragma unroll
        for (int ks = 0; ks < 4; ++ks) qf[ks] = qn[ks];
        if (i < 1) {
#pragma unroll
            for (int ks = 0; ks < 4; ++ks) qn[ks] = __builtin_bit_cast(bf16x8, ld8_bf16(QM + (row + 16) * 512 + h * 128 + ks * 32 + fq * 8)); }
        f32x4 o[8];
        attn_group<128, 16, false>(Kl, KSTR, Vl, VSTR, qf, 0, 0, 0.f, 0.f, 0.08838834764831845f, fr, fq, o);
#pragma unroll
        for (int dt = 0; dt < 8; ++dt) { u32x2 w; w.x = pk2(o[dt][0], o[dt][1]); w.y = pk2(o[dt][2], o[dt][3]); *(u32x2*)(OM + row * 512 + h * 128 + dt * 16 + fq * 4) = w; } }
    LDS_BARRIER();
}
__device__ __forceinline__ void mem_attn_sample_unit(int unit, const bf16* QM, const float* cK, const float* cV, bf16* OM, LAS unsigned char* lds, int tid, int wave, int lane) {
    constexpr int KSTR = 272, VSTR = 520; LAS unsigned char* Kl = lds; LAS unsigned char* Vl = lds + 256 * KSTR;
    const int h = unit & 3, b = unit >> 2; const int fr = lane & 15, fq = lane >> 4;
#pragma unroll 4
    for (int idx = tid; idx < 256 * 16; idx += 512) { const int kl = idx >> 4, dc = idx & 15; const size_t off = ((size_t)(b * 256 + kl) * 4 + h) * 128 + dc * 8;
        put_k(Kl, KSTR, kl, dc, ld8_f32(cK + off)); put_vt(Vl, VSTR, kl, dc, ld8_f32(cV + off)); }
    LDS_BARRIER();
    if (wave == 0) { const size_t row = (size_t)MP + b * 8 + (fr & 7);
        bf16x8 qf[4];
#pragma unroll
        for (int ks = 0; ks < 4; ++ks) qf[ks] = __builtin_bit_cast(bf16x8, ld8_bf16(QM + row * 512 + h * 128 + ks * 32 + fq * 8));
        f32x4 o[8];
        attn_group<128, 16, false>(Kl, KSTR, Vl, VSTR, qf, 0, 0, 0.f, 0.f, 0.08838834764831845f, fr, fq, o);
        if (fr < 8) {
#pragma unroll
            for (int dt = 0; dt < 8; ++dt) { u32x2 w; w.x = pk2(o[dt][0], o[dt][1]); w.y = pk2(o[dt][2], o[dt][3]); *(u32x2*)(OM + row * 512 + h * 128 + dt * 16 + fq * 4) = w; } } }
    LDS_BARRIER();
}

struct PassARaw { unsigned f[8], q[8], v[8]; };
__device__ __forceinline__ void hgrn_passA_load(PassARaw& R, int u, const bf16* Z, int tid) {
    const int c = u & 63, h = (u >> 6) & 7, b = u >> 9; const int chp = tid & 63, tq8 = tid >> 6;
    const bf16* zr = Z + ((size_t)b * SEQ + c * 64 + tq8 * 8) * NIN + h * 128 + chp * 2;
#pragma unroll
    for (int i = 0; i < 8; ++i) { R.f[i] = *(const unsigned*)(zr + (size_t)i * NIN + ZHF); R.q[i] = *(const unsigned*)(zr + (size_t)i * NIN + ZHQ); R.v[i] = *(const unsigned*)(zr + (size_t)i * NIN + ZHI); }
}
__device__ __forceinline__ void hgrn_passA4_sub(int u, int j, const PassARaw& R, const bf16* Z, const float* lbl, bf16* QH, bf16* OI, f32x4 (&uc)[8], float (&Lbase)[2], LAS unsigned char* lds, int tid, int wave, int lane) {
    constexpr int TOT = 0, QT = 4096, KT = QT + 64 * 272, KH = KT + 64 * 272, VT = KH + 128 * 144, AM = VT + 128 * 144, QL = AM + 64 * 144, UCT = QL + 64 * 272, DCL = UCT + 128 * 272;
    const int c = u & 63, h = (u >> 6) & 7, b = u >> 9; const int fr = lane & 15, fq = lane >> 4;
    const size_t r0 = (size_t)b * SEQ + c * 64;
    const int chp = tid & 63, tq8 = tid >> 6, c0 = chp * 2;
    {
        float lb[2], omlb[2];
#pragma unroll
        for (int cc = 0; cc < 2; ++cc) { const float l0 = lbl[h * 128 + c0 + cc], l1 = lbl[1024 + h * 128 + c0 + cc]; lb[cc] = 1.0f / (1.0f + __expf(l1 - l0)); omlb[cc] = 1.0f - lb[cc]; }
        float L[2][8], kk[2][8], qq[2][8]; float cum[2] = {0.f, 0.f};
#pragma unroll
        for (int i = 0; i < 8; ++i)
#pragma unroll
            for (int cc = 0; cc < 2; ++cc) { const float fraw = cc ? bfhi(R.f[i]) : bflo(R.f[i]), qraw = cc ? bfhi(R.q[i]) : bflo(R.q[i]);
                const float sg = sigmoidf_(fraw); cum[cc] += __logf(lb[cc] + omlb[cc] * sg); L[cc][i] = cum[cc]; kk[cc][i] = omlb[cc] * (1.0f - sg); qq[cc][i] = siluf_(qraw); }
        LAS float* tot = (LAS float*)(lds + TOT);
        *(LAS f32x2*)(tot + tq8 * 128 + c0) = (f32x2){cum[0], cum[1]};
        LDS_BARRIER();
        float pre[2] = {0.f, 0.f}, Lmid[2] = {0.f, 0.f}, Lend[2] = {0.f, 0.f};
#pragma unroll
        for (int g = 0; g < 8; ++g) { const f32x2 tv = *(const LAS f32x2*)(tot + g * 128 + c0);
#pragma unroll
            for (int cc = 0; cc < 2; ++cc) { pre[cc] += (g < tq8) ? tv[cc] : 0.f; Lmid[cc] += (g < 4) ? tv[cc] : 0.f; Lend[cc] += tv[cc]; } }
        unsigned kh[2][4], vp[2][4];
#pragma unroll
        for (int i = 0; i < 8; ++i) { const int t = tq8 * 8 + i; float qt[2], kt[2], qlv[2], qhv[2]; unsigned short khv[2];
#pragma unroll
            for (int cc = 0; cc < 2; ++cc) { const float Lt = pre[cc] + L[cc][i];
                qt[cc] = qq[cc][i] * __expf(fminf(Lt - Lmid[cc], 80.f)); kt[cc] = kk[cc][i] * __expf(fminf(Lmid[cc] - Lt, 80.f));
                qlv[cc] = qq[cc][i] * __expf(Lt); qhv[cc] = qq[cc][i] * __expf(Lbase[cc] + Lt); khv[cc] = f2bf(kk[cc][i] * __expf(Lend[cc] - Lt)); }
            *(LAS unsigned*)(lds + QT + t * 272 + c0 * 2) = pk2(qt[0], qt[1]); *(LAS unsigned*)(lds + KT + t * 272 + c0 * 2) = pk2(kt[0], kt[1]);
            *(LAS unsigned*)(lds + QL + t * 272 + c0 * 2) = pk2(qlv[0], qlv[1]);
            *(unsigned*)(QH + (r0 + t) * 1024 + h * 128 + c0) = pk2(qhv[0], qhv[1]);
            const unsigned v0 = R.v[i] & 0xffffu, v1 = R.v[i] >> 16;
            if (i & 1) { kh[0][i >> 1] |= (unsigned)khv[0] << 16; kh[1][i >> 1] |= (unsigned)khv[1] << 16; vp[0][i >> 1] |= v0 << 16; vp[1][i >> 1] |= v1 << 16; }
            else { kh[0][i >> 1] = khv[0]; kh[1][i >> 1] = khv[1]; vp[0][i >> 1] = v0; vp[1][i >> 1] = v1; } }
#pragma unroll
        for (int cc = 0; cc < 2; ++cc) { *(LAS u32x4*)(lds + KH + (c0 + cc) * 144 + tq8 * 16) = (u32x4){kh[cc][0], kh[cc][1], kh[cc][2], kh[cc][3]};
            *(LAS u32x4*)(lds + VT + (c0 + cc) * 144 + tq8 * 16) = (u32x4){vp[cc][0], vp[cc][1], vp[cc][2], vp[cc][3]}; }
        if (tq8 == 0) *(LAS f32x2*)(lds + DCL + c0 * 4) = (f32x2){__expf(Lend[0]), __expf(Lend[1])};
        Lbase[0] += Lend[0]; Lbase[1] += Lend[1];
    }
    LDS_BARRIER();
    {
        const int ti = wave >> 1;
#pragma unroll
        for (int q = 0; q < 2; ++q) { const int si = (wave & 1) * 2 + q; f32x4 a = (f32x4){0.f, 0.f, 0.f, 0.f};
#pragma unroll
            for (int ks = 0; ks < 4; ++ks) { const bf16x8 af = *(const LAS bf16x8*)(lds + QT + (ti * 16 + fr) * 272 + (ks * 32 + fq * 8) * 2), bfv = *(const LAS bf16x8*)(lds + KT + (si * 16 + fr) * 272 + (ks * 32 + fq * 8) * 2);
                a = MFMA16(af, bfv, a); }
#pragma unroll
            for (int jj = 0; jj < 4; ++jj) { const int t = ti * 16 + fq * 4 + jj, s = si * 16 + fr; const float v = (s <= t) ? a[jj] : 0.f; *(LAS unsigned short*)(lds + AM + t * 144 + s * 2) = f2bf(v); } }
    }
    LDS_BARRIER();
    {
        const int ti = wave >> 1; bf16x8 bm[2], ql[4];
#pragma unroll
        for (int kk = 0; kk < 2; ++kk) bm[kk] = *(const LAS bf16x8*)(lds + AM + (ti * 16 + fr) * 144 + (kk * 32 + fq * 8) * 2);
#pragma unroll
        for (int ks = 0; ks < 4; ++ks) ql[ks] = *(const LAS bf16x8*)(lds + QL + (ti * 16 + fr) * 272 + (ks * 32 + fq * 8) * 2);
#pragma unroll
        for (int q = 0; q < 4; ++q) { const int dvt = (wave & 1) * 4 + q; f32x4 o = (f32x4){0.f, 0.f, 0.f, 0.f};
#pragma unroll
            for (int kk = 0; kk < 2; ++kk) { const bf16x8 af = *(const LAS bf16x8*)(lds + VT + (dvt * 16 + fr) * 144 + (kk * 32 + fq * 8) * 2); o = MFMA16(af, bm[kk], o); }
            if (j > 0) {
#pragma unroll
                for (int ks = 0; ks < 4; ++ks) { const bf16x8 sf = *(const LAS bf16x8*)(lds + UCT + (dvt * 16 + fr) * 272 + (ks * 32 + fq * 8) * 2); o = MFMA16(sf, ql[ks], o); } }
            *(u32x2*)(OI + (r0 + ti * 16 + fr) * 1024 + h * 128 + dvt * 16 + fq * 4) = (u32x2){pk2(o[0], o[1]), pk2(o[2], o[3])}; }
        bf16x8 ka[2];
#pragma unroll
        for (int kk = 0; kk < 2; ++kk) ka[kk] = *(const LAS bf16x8*)(lds + KH + (wave * 16 + fr) * 144 + (kk * 32 + fq * 8) * 2);
        const f32x4 dvec = *(const LAS f32x4*)(lds + DCL + (wave * 16 + fq * 4) * 4);
#pragma unroll
        for (int dvt = 0; dvt < 8; ++dvt) { f32x4 uu = uc[dvt] * dvec;
#pragma unroll
            for (int kk = 0; kk < 2; ++kk) { const bf16x8 bv = *(const LAS bf16x8*)(lds + VT + (dvt * 16 + fr) * 144 + (kk * 32 + fq * 8) * 2); uu = MFMA16(ka[kk], bv, uu); }
            uc[dvt] = uu; }
    }
    LDS_BARRIER();
#pragma unroll
    for (int dvt = 0; dvt < 8; ++dvt) *(LAS u32x2*)(lds + UCT + (dvt * 16 + fr) * 272 + (wave * 16 + fq * 4) * 2) = (u32x2){pk2(uc[dvt][0], uc[dvt][1]), pk2(uc[dvt][2], uc[dvt][3])};
}
__device__ __forceinline__ void hgrn_passB(const bf16* UT, const float* DC, bf16* ST, float* PH, int gtid, int gthreads) {
    for (int e = gtid; e < 32 * 4096; e += gthreads) { const int seq = e >> 12, rem = e & 4095, dv = rem >> 5, dk = (rem & 31) * 4;
        u32x2 uw[16]; f32x4 Dv[16];
#pragma unroll
        for (int c = 0; c < 16; ++c) { const size_t u = (size_t)seq * 16 + c; uw[c] = *(const u32x2*)(UT + u * 16384 + dv * 128 + dk); Dv[c] = *(const f32x4*)(DC + u * 128 + dk); }
        f32x4 S = (f32x4){0.f, 0.f, 0.f, 0.f};
#pragma unroll
        for (int c = 0; c < 16; ++c) { const size_t u = (size_t)seq * 16 + c;
            const f32x4 U = (f32x4){bflo(uw[c].x), bfhi(uw[c].x), bflo(uw[c].y), bfhi(uw[c].y)};
            u32x2 w; w.x = pk2(S[0], S[1]); w.y = pk2(S[2], S[3]); *(u32x2*)(ST + u * 16384 + dv * 128 + dk) = w;
            S = Dv[c] * S + U; }
#pragma unroll
        for (int j = 0; j < 4; ++j) PH[(size_t)seq * 16384 + (dk + j) * 128 + dv] = S[j];
    }
}
struct PassCRaw { u32x4 q[4]; u32x2 o[4]; u32x4 s[16]; };
__device__ __forceinline__ void hgrn_passC_load(PassCRaw& R, int u, const bf16* QH, const bf16* OI, const bf16* ST, int wave, int lane) {
    const int c = u & 63, h = (u >> 6) & 7, b = u >> 9; const int fr = lane & 15, fq = lane >> 4; const size_t row = (size_t)b * SEQ + c * 64 + (wave >> 1) * 16 + fr;
#pragma unroll
    for (int ks = 0; ks < 4; ++ks) R.q[ks] = ld8_bf16(QH + row * 1024 + h * 128 + ks * 32 + fq * 8);
#pragma unroll
    for (int q = 0; q < 4; ++q) R.o[q] = *(const u32x2*)(OI + row * 1024 + h * 128 + ((wave & 1) * 4 + q) * 16 + fq * 4);
#pragma unroll
    for (int q = 0; q < 4; ++q)
#pragma unroll
        for (int ks = 0; ks < 4; ++ks) R.s[q * 4 + ks] = ld8_bf16(ST + (size_t)(u >> 2) * 16384 + (((wave & 1) * 4 + q) * 16 + fr) * 128 + ks * 32 + fq * 8);
}
__device__ __forceinline__ void hgrn_passC_unit(int u, const PassCRaw& R, bf16* HB, int wave, int lane) {
    const int c = u & 63, h = (u >> 6) & 7, b = u >> 9; const int fr = lane & 15, fq = lane >> 4; const size_t r0 = (size_t)b * SEQ + c * 64;
    const int ti = wave >> 1; const size_t row = r0 + ti * 16 + fr;
#pragma unroll
    for (int q = 0; q < 4; ++q) { const int dvt = (wave & 1) * 4 + q;
        f32x4 o = (f32x4){bflo(R.o[q].x), bfhi(R.o[q].x), bflo(R.o[q].y), bfhi(R.o[q].y)};
#pragma unroll
        for (int ks = 0; ks < 4; ++ks) o = MFMA16(__builtin_bit_cast(bf16x8, R.s[q * 4 + ks]), __builtin_bit_cast(bf16x8, R.q[ks]), o);
        u32x2 w; w.x = pk2(o[0], o[1]); w.y = pk2(o[2], o[3]); *(u32x2*)(HB + row * DM + 1024 + h * 128 + dvt * 16 + fq * 4) = w; }
}
__device__ __forceinline__ void hgrn_sample_unit(int unit, const bf16* Z, const float* lbl, const float* S0, float* S1, bf16* HB, LAS unsigned char* lds, int tid) {
    LAS float* Fl = (LAS float*)lds; LAS float* Kk = Fl + 1024; LAS float* Qq = Fl + 2048; LAS float* Vv = Fl + 3072; LAS float* red = Fl + 4096;
    const int h = unit & 7, b = unit >> 3; const size_t r0 = (size_t)MP + b * 8;
    const int dv4 = tid & 31, dkg = tid >> 5; const size_t sb = (size_t)unit * 16384;
    f32x4 S[8], op[8];
#pragma unroll
    for (int i = 0; i < 8; ++i) S[i] = *(const f32x4*)(S0 + sb + (dkg * 8 + i) * 128 + dv4 * 4);
    if (tid < 128) { const int ch = tid; const float l0 = lbl[h * 128 + ch], l1 = lbl[1024 + h * 128 + ch]; const float lb = 1.0f / (1.0f + __expf(l1 - l0)), omlb = 1.0f - lb;
#pragma unroll
        for (int t = 0; t < 8; ++t) { const bf16* zr = Z + (r0 + t) * NIN + h * 128 + ch; const float fraw = bf2f(zr[ZHF]), qraw = bf2f(zr[ZHQ]); const float sg = sigmoidf_(fraw);
            Fl[t * 128 + ch] = lb + omlb * sg; Kk[t * 128 + ch] = omlb * (1.0f - sg); Qq[t * 128 + ch] = siluf_(qraw); } }
    else if (tid < 256) { const int ch = tid - 128;
#pragma unroll
        for (int t = 0; t < 8; ++t) Vv[t * 128 + ch] = bf2f(Z[(r0 + t) * NIN + ZHI + h * 128 + ch]); }
    LDS_BARRIER();
#pragma unroll
    for (int t = 0; t < 8; ++t) { const f32x4 v = *(const LAS f32x4*)(Vv + t * 128 + dv4 * 4); f32x4 acc = (f32x4){0.f, 0.f, 0.f, 0.f};
#pragma unroll
        for (int i = 0; i < 8; ++i) { const int dk = dkg * 8 + i; const float f = Fl[t * 128 + dk], k = Kk[t * 128 + dk], q = Qq[t * 128 + dk]; S[i] = S[i] * f + v * k; acc = acc + S[i] * q; }
        op[t] = acc; }
#pragma unroll
    for (int i = 0; i < 8; ++i) *(f32x4*)(S1 + sb + (dkg * 8 + i) * 128 + dv4 * 4) = S[i];
#pragma unroll
    for (int t = 0; t < 8; ++t) *(LAS f32x4*)(red + (dkg * 8 + t) * 128 + dv4 * 4) = op[t];
    LDS_BARRIER();
    for (int o = tid; o < 1024; o += 512) { const int t = o >> 7, dv = o & 127; float s = 0.f;
#pragma unroll
        for (int g = 0; g < 16; ++g) s += red[(g * 8 + t) * 128 + dv];
        HB[(r0 + t) * DM + 1024 + h * 128 + dv] = f2bf(s); }
    LDS_BARRIER();
}
__device__ __forceinline__ void mix_norm_rows(bf16* HB, const bf16* Z, const float* ga, const float* gh, int gw, int NGW, int lane) {
    float gav[16], ghv[16];
#pragma unroll
    for (int i = 0; i < 8; ++i) { gav[i] = ga[lane * 8 + i]; gav[8 + i] = ga[512 + lane * 8 + i]; }
#pragma unroll
    for (int i = 0; i < 16; ++i) ghv[i] = gh[(lane & 7) * 16 + i];
    int row = gw;
    u32x4 c[6], n[6];
#pragma unroll
    for (int i = 0; i < 6; ++i) { c[i] = (u32x4){0u, 0u, 0u, 0u}; n[i] = c[i]; }
    if (row < MT) { const bf16* hr = HB + (size_t)row * DM; const bf16* zr = Z + (size_t)row * NIN + ZHG + lane * 16;
        c[0] = *(const u32x4*)(hr + lane * 8); c[1] = *(const u32x4*)(hr + 512 + lane * 8); c[2] = *(const u32x4*)(hr + 1024 + lane * 16); c[3] = *(const u32x4*)(hr + 1024 + lane * 16 + 8);
        c[4] = *(const u32x4*)zr; c[5] = *(const u32x4*)(zr + 8); }
    while (row < MT) {
        const int nrow = row + NGW;
        if (nrow < MT) { const bf16* hr = HB + (size_t)nrow * DM; const bf16* zr = Z + (size_t)nrow * NIN + ZHG + lane * 16;
            n[0] = *(const u32x4*)(hr + lane * 8); n[1] = *(const u32x4*)(hr + 512 + lane * 8); n[2] = *(const u32x4*)(hr + 1024 + lane * 16); n[3] = *(const u32x4*)(hr + 1024 + lane * 16 + 8);
            n[4] = *(const u32x4*)zr; n[5] = *(const u32x4*)(zr + 8); }
        bf16* hr = HB + (size_t)row * DM;
        {   float v[16];
#pragma unroll
            for (int i = 0; i < 4; ++i) { v[2 * i] = bflo(c[0][i]); v[2 * i + 1] = bfhi(c[0][i]); v[8 + 2 * i] = bflo(c[1][i]); v[8 + 2 * i + 1] = bfhi(c[1][i]); }
            float ss = 0.f;
#pragma unroll
            for (int i = 0; i < 16; ++i) ss += v[i] * v[i];
            const float rstd = rsqrtf(wave_sum(ss) * (1.0f / 1024.0f) + EPS);
#pragma unroll
            for (int i = 0; i < 16; ++i) v[i] *= rstd * gav[i];
            *(u32x4*)(hr + lane * 8) = (u32x4){pk2(v[0], v[1]), pk2(v[2], v[3]), pk2(v[4], v[5]), pk2(v[6], v[7])};
            *(u32x4*)(hr + 512 + lane * 8) = (u32x4){pk2(v[8], v[9]), pk2(v[10], v[11]), pk2(v[12], v[13]), pk2(v[14], v[15])}; }
        {   float v[16], g[16];
#pragma unroll
            for (int i = 0; i < 4; ++i) { v[2 * i] = bflo(c[2][i]); v[2 * i + 1] = bfhi(c[2][i]); v[8 + 2 * i] = bflo(c[3][i]); v[8 + 2 * i + 1] = bfhi(c[3][i]);
                g[2 * i] = bflo(c[4][i]); g[2 * i + 1] = bfhi(c[4][i]); g[8 + 2 * i] = bflo(c[5][i]); g[8 + 2 * i + 1] = bfhi(c[5][i]); }
            float ss = 0.f;
#pragma unroll
            for (int i = 0; i < 16; ++i) ss += v[i] * v[i];
            ss += __shfl_xor(ss, 1); ss += __shfl_xor(ss, 2); ss += __shfl_xor(ss, 4);
            const float rstd = rsqrtf(ss * (1.0f / 128.0f) + EPS);
#pragma unroll
            for (int i = 0; i < 16; ++i) v[i] = v[i] * rstd * ghv[i] * siluf_(g[i]);
            *(u32x4*)(hr + 1024 + lane * 16) = (u32x4){pk2(v[0], v[1]), pk2(v[2], v[3]), pk2(v[4], v[5]), pk2(v[6], v[7])};
            *(u32x4*)(hr + 1024 + lane * 16 + 8) = (u32x4){pk2(v[8], v[9]), pk2(v[10], v[11]), pk2(v[12], v[13]), pk2(v[14], v[15])}; }
#pragma unroll
        for (int i = 0; i < 6; ++i) c[i] = n[i];
        row = nrow;
    }
}
__device__ __forceinline__ void win_outputs(const bf16* Z, const float* cK, const float* cV, float* out, int gtid, int gthreads) {
    for (int e = gtid; e < 2 * 4 * 128 * 64; e += gthreads) { const int which = e >> 15, r = e & 32767, c4 = (r & 63) * 4, t = (r >> 6) & 127, b = r >> 13;
        const bf16* z = Z + (size_t)(b * SEQ + SEQ - 128 + t) * NIN + (which ? ZVA : ZKA) + c4; const u32x2 w = *(const u32x2*)z;
        *(f32x4*)(out + (which ? O_PWV : O_PWK) + ((size_t)(b * 128 + t) * 256 + c4)) = (f32x4){bflo(w.x), bfhi(w.x), bflo(w.y), bfhi(w.y)}; }
    for (int e = gtid; e < 2 * 128 * 8 * 64; e += gthreads) { const int which = e >> 16, r = e & 65535, c4 = (r & 63) * 4, t = (r >> 6) & 7, b = r >> 9;
        const bf16* z = Z + (size_t)(MP + b * 8 + t) * NIN + (which ? ZVA : ZKA) + c4; const u32x2 w = *(const u32x2*)z;
        *(f32x4*)(out + (which ? O_SWV : O_SWK) + ((size_t)(b * 128 + 120 + t) * 256 + c4)) = (f32x4){bflo(w.x), bfhi(w.x), bflo(w.y), bfhi(w.y)}; }
}
__device__ __forceinline__ void win_cache_copy(const float* cK, const float* cV, float* out, int gtid, int gthreads) {
    constexpr int BLK = 120 * 64, TOT = 2 * 128 * BLK;
    for (int e0 = gtid; e0 < TOT; e0 += 8 * gthreads) { f32x4 v[8];
#pragma unroll
        for (int k = 0; k < 8; ++k) { const int e = e0 + k * gthreads; if (e < TOT) { const int wb = e / BLK, i = e - wb * BLK, which = wb >> 7, b = wb & 127; v[k] = *(const f32x4*)((which ? cV : cK) + (size_t)(b * 128 + 8) * 256 + (size_t)i * 4); } }
#pragma unroll
        for (int k = 0; k < 8; ++k) { const int e = e0 + k * gthreads; if (e < TOT) { const int wb = e / BLK, i = e - wb * BLK, which = wb >> 7, b = wb & 127; *(f32x4*)(out + (which ? O_SWV : O_SWK) + (size_t)(b * 128) * 256 + (size_t)i * 4) = v[k]; } } }
}

#define RLX_AGENT __ATOMIC_RELAXED, __HIP_MEMORY_SCOPE_AGENT
#define XB_TMO      128
#define XB_XCNT(j)  (256  + 64 * (j))
#define XB_XSUB(j)  (1280 + 64 * (j))
#define XB_XGEN(j)  (2304 + 64 * (j))
#define XB_TOP      3328
#define XB_TOPGEN   3392
#define XCD_BAR_WORDS 3456
#define XB_SPIN_CAP (1u << 18)

__device__ __forceinline__ unsigned xb_ld(unsigned* p)              { return __hip_atomic_load(p, __ATOMIC_RELAXED, __HIP_MEMORY_SCOPE_AGENT); }
__device__ __forceinline__ unsigned xb_add(unsigned* p, unsigned v) { return __hip_atomic_fetch_add(p, v, __ATOMIC_RELAXED, __HIP_MEMORY_SCOPE_AGENT); }
__device__ __forceinline__ unsigned xb_xcc_id() { return (unsigned)__builtin_amdgcn_s_getreg((3 << 11) | 20) & 0xFu; }
#define XB_SPIN(cond, bar) do { unsigned _sp = 0; while (cond) { __builtin_amdgcn_s_sleep(1); \
    if ((++_sp & 255u) == 0u) { if (xb_ld(&(bar)[XB_TMO])) break; if (_sp > XB_SPIN_CAP) { atomicAdd(&(bar)[XB_TMO], 1u); break; } } } } while (0)

struct XcdBarrier {
    unsigned* bar; unsigned x;
    volatile LAS unsigned* st;
};

__device__ __forceinline__ XcdBarrier xcd_barrier_post(unsigned* bar, volatile LAS unsigned* st) {
    XcdBarrier b; b.bar = bar; b.x = xb_xcc_id(); b.st = st;
    if (threadIdx.x == 0) (void)xb_add(&bar[XB_XCNT(b.x)], 1u);
    return b;
}
__device__ __forceinline__ void xcd_barrier_complete(unsigned* bar, unsigned x, unsigned& nloc, unsigned& nx) {
    const unsigned G = gridDim.x * gridDim.y * gridDim.z;
    unsigned sum, cnt, mine, sp = 0u;
    for (;;) {
        sum = 0u; cnt = 0u; mine = 0u;
#pragma unroll
        for (unsigned j = 0; j < 16; ++j) { const unsigned c = xb_ld(&bar[XB_XCNT(j)]); sum += c; cnt += (c > 0u) ? 1u : 0u; mine = (j == x) ? c : mine; }
        if (sum == G) break;
        __builtin_amdgcn_s_sleep(1);
        if ((++sp & 255u) == 0u) { if (xb_ld(&bar[XB_TMO])) break; if (sp > XB_SPIN_CAP) { atomicAdd(&bar[XB_TMO], 1u); break; } }
    }
    nloc = mine > 0u ? mine : 1u; nx = cnt > 0u ? cnt : 1u;
}

__device__ __forceinline__ void xcd_barrier(const XcdBarrier& b) {
    asm volatile("s_waitcnt vmcnt(0)" ::: "memory");
    __syncthreads();
    if (threadIdx.x == 0) {
        unsigned* bar = b.bar;
        __builtin_amdgcn_s_waitcnt(0);
        unsigned nloc = b.st[0], nx = b.st[1];
        if (nloc == 0u) { xcd_barrier_complete(bar, b.x, nloc, nx); b.st[0] = nloc; b.st[1] = nx; }
        const unsigned old = xb_add(&bar[XB_XSUB(b.x)], 1u);
        const unsigned gen = old / nloc;
        if (old + 1u == (gen + 1u) * nloc) {
            __builtin_amdgcn_fence(__ATOMIC_RELEASE, "agent");
            asm volatile("s_waitcnt vmcnt(0)" ::: "memory");
            const unsigned og = xb_add(&bar[XB_TOP], 1u);
            const unsigned tg = og / nx;
            if (og + 1u == (tg + 1u) * nx) xb_add(&bar[XB_TOPGEN], 1u);
            else XB_SPIN(xb_ld(&bar[XB_TOPGEN]) == tg, bar);
            __builtin_amdgcn_fence(__ATOMIC_ACQUIRE, "agent");
            xb_add(&bar[XB_XGEN(b.x)], 1u);
            asm volatile("s_waitcnt vmcnt(0)" ::: "memory");
        } else {
            XB_SPIN(xb_ld(&bar[XB_XGEN(b.x)]) == gen, bar);
            __builtin_amdgcn_fence(__ATOMIC_ACQUIRE, "agent");
            asm volatile("s_waitcnt vmcnt(0)" ::: "memory");
        }
    }
    __syncthreads();
}

__global__ void __launch_bounds__(512, 2) mega_fwd(Params p) {
    extern __shared__ __attribute__((aligned(16))) unsigned char lds_raw[];
    cg::grid_group grid = cg::this_grid();
    LAS unsigned char* lds = (LAS unsigned char*)lds_raw;
    const int tid = threadIdx.x, lane = tid & 63, wave = __builtin_amdgcn_readfirstlane(tid >> 6);
    const int G = gridDim.x, bx = blockIdx.x, gw = bx * 8 + wave, NGW = G * 8, gtid = bx * 512 + tid, gthreads = G * 512;
    unsigned char* ws = p.ws; float* out = p.out;
    bf16* W_GU = (bf16*)(ws + WS_WGU); bf16* W_D = (bf16*)(ws + WS_WD); bf16* W_IN = (bf16*)(ws + WS_WIN); bf16* W_OUT = (bf16*)(ws + WS_WOUT);
    bf16* W_MQ = (bf16*)(ws + WS_WMQ); bf16* W_MKV = (bf16*)(ws + WS_WMKV); bf16* W_MO = (bf16*)(ws + WS_WMO); bf16* MEMN = (bf16*)(ws + WS_MEMN);
    bf16* MK = (bf16*)(ws + WS_MK); bf16* MV = (bf16*)(ws + WS_MV); float* DC = (float*)(ws + WS_DC); bf16* HB = (bf16*)(ws + WS_HBUF);
    bf16* ACT = (bf16*)(ws + WS_ACT); bf16* Z = ACT; bf16* Fm = (bf16*)(ws + WS_F); bf16* UT = (bf16*)(ws + WS_F);     bf16* OI = (bf16*)(ws + WS_OI + 64 * MiB - 32 * MiB); float* PART = (float*)(ws + WS_OI);
    bf16* QH = (bf16*)(ws + WS_QH); bf16* ST = (bf16*)(ws + WS_ST); bf16* QM = (bf16*)(ws + WS_QMEM); bf16* OM = (bf16*)(ws + WS_OMEM);
    float* X = out + O_Y;
    bf16* XB = (bf16*)(ws + WS_XB);
    LAS float* scr = (LAS float*)(lds + wave * 8448);
    volatile LAS unsigned* bst = (volatile LAS unsigned*)(lds + LDS_BYTES - 64);
    if (tid < 16) bst[tid] = 0u;
    __syncthreads();
    XcdBarrier xbar = xcd_barrier_post((unsigned*)(ws + WS_BAR), bst);
#define GSYNC() xcd_barrier(xbar)

    if (PHMASK & (1u << 0)) {
    wt_matrix(p.in[10], DM, DFF, W_GU, 1, 0, scr, gw, NGW, lane);
    wt_matrix(p.in[11], DM, DFF, W_GU, 2, 0, scr, gw, NGW, lane);
    norm_rows<0, false, true, false, 0>(nullptr, nullptr, p.in[0], p.in[1], MP, MT, nullptr, nullptr, nullptr, 0.f, nullptr, p.in[8], HB, lds, tid, gw, NGW, lane);
    norm_rows<0, false, true, false, 0>(nullptr, nullptr, p.in[2], p.in[2], 1024, 1024, nullptr, nullptr, nullptr, 0.f, nullptr, p.in[23], MEMN, lds, tid, gw, NGW, lane);
    }
    GSYNC();
    if (PHMASK & (1u << 1)) {
    { pg8::Gemm g{HB, W_GU, MT, 2 * DFF, DM}; pg8::StaticOrder S; S.init(MT, 2 * DFF, G, bx, DM); pg8::EpiSwiglu E{ACT, DFF};
      pg8::gemm_phase<pg8::EpiSwiglu, pg8::StaticOrder, true, true>(lds, g, S, E); }
    if (G == 256 && bx >= 176) {
        const int gw2 = (bx - 176) * 8 + wave, ngw2 = 80 * 8;
        wt_matrix(p.in[12], DFF, DM, W_D, 0, 0, scr, gw2, ngw2, lane);
        wt_matrix(p.in[15], DM, NIN, W_IN, 0, 0, scr, gw2, ngw2, lane); }
    else if (G != 256) { wt_matrix(p.in[12], DFF, DM, W_D, 0, 0, scr, gw, NGW, lane); wt_matrix(p.in[15], DM, NIN, W_IN, 0, 0, scr, gw, NGW, lane); }
    }
    GSYNC();
    if (PHMASK & (1u << 2)) {
    { pg8::Gemm g{ACT, W_D, MT, DM, DFF}; pg8::TailOrder S; S.init(DM, G, bx, DFF); pg8::EpiF32 E{Fm, DM, PART};
      pg8::gemm_phase<pg8::EpiF32, pg8::TailOrder, true, true>(lds, g, S, E); }
    }
    GSYNC();
    if (PHMASK & (1u << 3)) {
    norm_rows<0, true, true, true, 1>(Fm, PART, p.in[0], p.in[1], MP, MT, nullptr, XB, nullptr, 0.5f, p.in[9], p.in[13], HB, lds, tid, gw, NGW, lane);
    }
    GSYNC();
    if (PHMASK & (1u << 4)) {
    { pg8::Gemm g{HB, W_IN, MT, NIN, DM}; pg8::StaticOrder S; S.init(MT, NIN, G, bx, DM); pg8::EpiBf16 E{Z, NIN};
      pg8::gemm_phase<pg8::EpiBf16, pg8::StaticOrder, true, true>(lds, g, S, E); }
    { const bool tail = (G == 256 && bx >= 216); const int gw2 = tail ? (bx - 216) * 8 + wave : gw, ngw2 = tail ? 40 * 8 : NGW;
      if (tail || G != 256) {
        wt_matrix(p.in[20], DM, DM, W_OUT, 0, 0, scr, gw2, ngw2, lane);
        wt_matrix(p.in[24], DM, 512, W_MQ, 0, 0, scr, gw2, ngw2, lane);
        wt_matrix(p.in[25], DM, 512, W_MKV, 0, 0, scr, gw2, ngw2, lane);
        wt_matrix(p.in[26], DM, 512, W_MKV, 0, 512, scr, gw2, ngw2, lane);
        wt_matrix(p.in[27], 512, DM, W_MO, 0, 0, scr, gw2, ngw2, lane); } }
    }
    GSYNC();
    if (PHMASK & (1u << 5)) {
    { PassARaw Rc, Rn; f32x4 uc[8]; float Lbase[2] = {0.f, 0.f};
#pragma unroll
      for (int i = 0; i < 8; ++i) uc[i] = (f32x4){0.f, 0.f, 0.f, 0.f};
      int U = bx, j = 0;
      if (U < 512) hgrn_passA_load(Rc, (U >> 4) * 64 + (U & 15) * 4, Z, tid);
      while (U < 512) {
          int Un = U, jn = j + 1; if (jn == 4) { jn = 0; Un = U + G; }
          if (Un < 512) hgrn_passA_load(Rn, (Un >> 4) * 64 + (Un & 15) * 4 + jn, Z, tid);
          if (j == 0) { Lbase[0] = 0.f; Lbase[1] = 0.f;
#pragma unroll
              for (int i = 0; i < 8; ++i) uc[i] = (f32x4){0.f, 0.f, 0.f, 0.f}; }
          hgrn_passA4_sub((U >> 4) * 64 + (U & 15) * 4 + j, j, Rc, Z, p.in[17], QH, OI, uc, Lbase, lds, tid, wave, lane);
          if (j == 3) { const int fr = lane & 15, fq = lane >> 4;
#pragma unroll
              for (int dvt = 0; dvt < 8; ++dvt) *(u32x2*)(UT + (size_t)U * 16384 + (dvt * 16 + fr) * 128 + wave * 16 + fq * 4) = (u32x2){pk2(uc[dvt][0], uc[dvt][1]), pk2(uc[dvt][2], uc[dvt][3])};
              if (tid < 64) { DC[(size_t)U * 128 + 2 * tid] = __expf(Lbase[0]); DC[(size_t)U * 128 + 2 * tid + 1] = __expf(Lbase[1]); } }
          Rc = Rn; U = Un; j = jn; }
      __syncthreads(); }
    for (int u = bx; u < 512; u += G) win_attn_prompt_unit(u, Z, HB, p.in[16], lds, tid, wave, lane);
    for (int u = bx; u < 512; u += G) win_attn_sample_unit(u, Z, p.in[3], p.in[4], HB, p.in[16], lds, tid, wave, lane);
    for (int u = bx; u < 1024; u += G) hgrn_sample_unit(u, Z, p.in[17], p.in[5], out + O_SH, HB, lds, tid);
    __syncthreads();
    win_outputs(Z, p.in[3], p.in[4], out, gtid, gthreads);
    }
    GSYNC();
    if (PHMASK & (1u << 6)) {
    hgrn_passB(UT, DC, ST, out + O_PH, gtid, gthreads);
    }
    GSYNC();
    if (PHMASK & (1u << 7)) {
    { PassCRaw Rc, Rn; int u = bx; if (u < 2048) hgrn_passC_load(Rc, u, QH, OI, ST, wave, lane);
      while (u < 2048) { const int un = u + G; if (un < 2048) hgrn_passC_load(Rn, un, QH, OI, ST, wave, lane);
          hgrn_passC_unit(u, Rc, HB, wave, lane); Rc = Rn; u = un; } }
    }
    GSYNC();
    if (PHMASK & (1u << 8)) {
    mix_norm_rows(HB, Z, p.in[18], p.in[19], gw, NGW, lane);
    }
    GSYNC();
    if (PHMASK & (1u << 9)) {
    { pg8::Gemm g{HB, W_OUT, MT, DM, DM}; pg8::TailOrder S; S.init(DM, G, bx, DM); pg8::EpiF32 E{Fm, DM, PART};
      pg8::gemm_phase<pg8::EpiF32, pg8::TailOrder, true, true>(lds, g, S, E); }
    }
    GSYNC();
    if (PHMASK & (1u << 10)) {
    norm_rows<1, true, true, true, 1>(Fm, PART, nullptr, nullptr, MT, MT, XB, XB, nullptr, 1.0f, p.in[14], p.in[21], HB, lds, tid, gw, NGW, lane);
    }
    GSYNC();
    if (PHMASK & (1u << 11)) {
    { pg8::Gemm g{HB, W_MQ, MT, 512, DM}; pg8::StaticOrder S; S.init(MT, 512, G, bx, DM); pg8::EpiBf16 E{QM, 512};
      pg8::gemm_phase<pg8::EpiBf16, pg8::StaticOrder, true, true>(lds, g, S, E); }
    { pg8::Gemm g{MEMN, W_MKV, 1024, 1024, DM}; pg8::StaticOrder S; S.init(1024, 1024, G, (bx + G - 136) % G, DM); pg8::EpiMemKV E{out + O_PMK, out + O_PMV, MK, MV};
      pg8::gemm_phase<pg8::EpiMemKV, pg8::StaticOrder, true, true>(lds, g, S, E); }
    { const bool tail = (G == 256 && bx >= 152); const int gw2 = tail ? (bx - 152) * 8 + wave : gw, ngw2 = tail ? 104 * 8 : NGW;
      if (tail || G != 256) {
        wt_matrix(p.in[32], DFF, DM, W_D, 0, 0, scr, gw2, ngw2, lane);
        wt_matrix(p.in[31], DM, DFF, W_GU, 2, 0, scr, gw2, ngw2, lane); } }
    }
    GSYNC();
    if (PHMASK & (1u << 12)) {
    for (int u = bx; u < 256; u += G) mem_attn_prompt_unit(u, QM, MK, MV, OM, lds, tid, wave, lane);
    for (int u = bx; u < 512; u += G) mem_attn_sample_unit(u, QM, p.in[6], p.in[7], OM, lds, tid, wave, lane);
    }
    GSYNC();
    if (PHMASK & (1u << 13)) {
    { pg8::Gemm g{OM, W_MO, MT, DM, 512}; pg8::StaticOrder S; S.init(MT, DM, G, bx, 512); pg8::EpiF32 E{Fm, DM, nullptr};
      pg8::gemm_phase<pg8::EpiF32, pg8::StaticOrder, true, true>(lds, g, S, E); }
    { const bool tail = (G == 256 && bx >= 32); const int gw2 = tail ? (bx - 32) * 8 + wave : gw, ngw2 = tail ? 224 * 8 : NGW;
      if (tail || G != 256) wt_matrix(p.in[30], DM, DFF, W_GU, 1, 0, scr, gw2, ngw2, lane); }
    }
    GSYNC();
    if (PHMASK & (1u << 14)) {
    norm_rows<1, true, true, false, 1>(Fm, nullptr, nullptr, nullptr, MT, MT, XB, XB, nullptr, 1.0f, p.in[22], p.in[28], HB, lds, tid, gw, NGW, lane);
    }
    GSYNC();
    if (PHMASK & (1u << 15)) {
    { pg8::Gemm g{HB, W_GU, MT, 2 * DFF, DM}; pg8::StaticOrder S; S.init(MT, 2 * DFF, G, bx, DM); pg8::EpiSwiglu E{ACT, DFF};
      pg8::gemm_phase<pg8::EpiSwiglu, pg8::StaticOrder, true, true>(lds, g, S, E); }
    if (G == 256) { if (bx >= 176) win_cache_copy(p.in[3], p.in[4], out, (bx - 176) * 512 + tid, 80 * 512); }
    else win_cache_copy(p.in[3], p.in[4], out, gtid, gthreads);
    }
    GSYNC();
    if (PHMASK & (1u << 16)) {
    { pg8::Gemm g{ACT, W_D, MT, DM, DFF}; pg8::TailOrder S; S.init(DM, G, bx, DFF); pg8::EpiF32 E{Fm, DM, PART};
      pg8::gemm_phase<pg8::EpiF32, pg8::TailOrder, true, true>(lds, g, S, E); }
    }
    GSYNC();
    if (PHMASK & (1u << 17)) {
    norm_rows<1, true, false, true, 2>(Fm, PART, nullptr, nullptr, MT, MT, XB, nullptr, X, 0.5f, p.in[29], nullptr, nullptr, lds, tid, gw, NGW, lane);
    }
    if (G == 0x7ffffff0) grid.sync();
}

extern "C" void kernel_launch(void* const* d_in, const int* in_sizes, int n_in, void* d_out, int out_size, void* d_ws, size_t ws_size, hipStream_t stream) {
    static int grid = 0;
    if (grid == 0) {
        if (n_in != 33 || ws_size < WS_END2) { fprintf(stderr, "kernel_launch: unexpected n_in %d / ws %zu\n", n_in, ws_size); grid = -1; return; }
        int dev = 0, cus = 0, per_cu = 0;
        hipGetDevice(&dev); hipDeviceGetAttribute(&cus, hipDeviceAttributeMultiprocessorCount, dev);
        hipFuncSetAttribute((const void*)mega_fwd, hipFuncAttributeMaxDynamicSharedMemorySize, LDS_BYTES);
        hipOccupancyMaxActiveBlocksPerMultiprocessor(&per_cu, (const void*)mega_fwd, 512, LDS_BYTES);
        if (per_cu < 1) { fprintf(stderr, "kernel_launch: occupancy query says %d blocks/CU\n", per_cu); per_cu = 1; }
        (void)hipGetLastError();
        grid = cus * 1;
    }
    if (grid < 0) return;
    if (hipMemsetAsync((char*)d_ws + WS_BAR, 0, 16384, stream) != hipSuccess) { fprintf(stderr, "memset failed\n"); return; }
    Params p{};
    for (int i = 0; i < 33; ++i) p.in[i] = (const float*)d_in[i];
    p.out = (float*)d_out; p.ws = (unsigned char*)d_ws;
    void* args[] = {&p};
    hipError_t e = hipLaunchCooperativeKernel((const void*)mega_fwd, dim3(grid), dim3(512), args, LDS_BYTES, stream);
    if (e != hipSuccess) fprintf(stderr, "cooperative launch failed: %s (grid %d)\n", hipGetErrorString(e), grid);
}
```

```cpp
#include <hip/hip_runtime.h>
#include <hip/hip_cooperative_groups.h>
#include <cstdio>
#include <cstdint>
namespace cg = cooperative_groups;

#define LAS __attribute__((address_space(3)))
typedef unsigned short bf16;
typedef short bf16x8 __attribute__((ext_vector_type(8)));
typedef short s16x4 __attribute__((ext_vector_type(4)));
typedef float f32x4 __attribute__((ext_vector_type(4)));
typedef float f32x2 __attribute__((ext_vector_type(2)));
typedef unsigned u32x4 __attribute__((ext_vector_type(4)));
typedef unsigned u32x2 __attribute__((ext_vector_type(2)));
typedef __bf16 bf16x2_t __attribute__((ext_vector_type(2)));

constexpr int DM = 2048, DFF = 5632, NIN = 5632;
constexpr int MP = 16384, MS = 1024, MT = MP + MS;
constexpr int SEQ = 4096, PAST = 16384;
constexpr int ZQA = 0, ZKA = 1024, ZVA = 1280, ZHQ = 1536, ZHF = 2560, ZHI = 3584, ZHG = 4608;
constexpr float EPS = 1e-6f;
constexpr size_t O_Y = 0, O_PWK = 35651584, O_PWV = 35782656, O_PH = 35913728, O_PMK = 36438016, O_PMV = 36962304,
                 O_SWK = 37486592, O_SWV = 41680896, O_SH = 45875200;
constexpr size_t MiB = 1048576;
constexpr size_t WS_WGU = 0, WS_WD = 44 * MiB, WS_WIN = 66 * MiB, WS_WOUT = 88 * MiB, WS_WMQ = 96 * MiB, WS_WMKV = 98 * MiB, WS_WMO = 102 * MiB,
                 WS_MEMN = 104 * MiB, WS_MK = 108 * MiB, WS_MV = 109 * MiB, WS_DC = 110 * MiB, WS_HBUF = 112 * MiB, WS_ACT = 180 * MiB, WS_F = 367 * MiB,
                 WS_OI = 503 * MiB, WS_QH = 567 * MiB, WS_ST = 599 * MiB, WS_END = 663 * MiB;
constexpr size_t WS_BAR = 111 * MiB, WS_XB = 435 * MiB, WS_END2 = 663 * MiB;
constexpr size_t WS_QMEM = WS_OI, WS_OMEM = WS_OI + 17 * MiB;
constexpr int LDS_BYTES = 147456;

__device__ __forceinline__ unsigned pk2(float lo, float hi) { f32x2 v = {lo, hi}; bf16x2_t b = __builtin_convertvector(v, bf16x2_t); return __builtin_bit_cast(unsigned, b); }
__device__ __forceinline__ unsigned short f2bf(float f) { return (unsigned short)(pk2(f, 0.f) & 0xffffu); }
__device__ __forceinline__ float bf2f(unsigned short b) { return __uint_as_float(((unsigned)b) << 16); }
__device__ __forceinline__ float bflo(unsigned w) { return __uint_as_float(w << 16); }
__device__ __forceinline__ float bfhi(unsigned w) { return __uint_as_float(w & 0xffff0000u); }
__device__ __forceinline__ float wave_sum(float v) {
#pragma unroll
    for (int o = 1; o < 64; o <<= 1) v += __shfl_xor(v, o);
    return v;
}
__device__ __forceinline__ float sigmoidf_(float x) { return __builtin_amdgcn_rcpf(1.0f + __expf(-x)); }
__device__ __forceinline__ float siluf_(float x) { return x * sigmoidf_(x); }

#ifndef PHMASK_DEF
#define PHMASK_DEF 0xFFFFFFFFu
#endif
constexpr unsigned PHMASK = PHMASK_DEF;
namespace pg8 {
#define PG8_LAS __attribute__((address_space(3)))
typedef unsigned short bf16_t;
typedef short bf16x8 __attribute__((ext_vector_type(8)));
typedef float f32x4 __attribute__((ext_vector_type(4)));
typedef unsigned u32x4 __attribute__((ext_vector_type(4)));
constexpr int BM = 256, BK = 64, HALF = 128, HTB = HALF * BK * 2  , STAGE_BYTES = 8 * HTB, NXCD = 8, WGM = 8;

__host__ __device__ __forceinline__ int lds_byte(int r, int c) { const int st = (r >> 4) * 2 + (c >> 5), rr = r & 15, cc = c & 31, ob = rr * 64 + cc * 2; return st * 1024 + (ob ^ (((ob >> 9) & 1) << 5)); }
__host__ __device__ __forceinline__ void stage_rc(int b, int& R, int& C) { const int st = b / 1024, sb = b % 1024, swz = sb ^ (((sb >> 9) & 1) << 5); R = (st >> 1) * 16 + swz / 64; C = (st & 1) * 32 + (swz % 64) / 2; }
__host__ __device__ __forceinline__ int perm32(int rho) { const int n = rho >> 4, i = rho & 15; return 8 * (i >> 2) + 4 * n + (i & 3); }

struct Unit { int pm, pn, k0, nt, sp; };
struct Gemm { const bf16_t* A; const bf16_t* Bt; int M, N, K; };

struct StaticOrder {
    int nM, nN, nwg, G, c, ntf;
    __host__ __device__ void init(int M, int N, int G_, int c_, int K_) { nM = M / BM; nN = N / BM; nwg = nM * nN; G = G_; c = c_; ntf = K_ / BK; }
    __host__ __device__ __forceinline__ Unit get(int i) const {
        Unit u; u.pm = 0; u.pn = 0; u.k0 = 0; u.nt = 0; u.sp = -1;
        const long L = (long)i * G + c; if (L >= nwg) return u;
        int wgid = (int)L; { const int q = nwg / NXCD, r = nwg % NXCD, xcd = wgid % NXCD, off = wgid / NXCD; wgid = (xcd < r ? xcd * (q + 1) : r * (q + 1) + (xcd - r) * q) + off; }
        const int nig = WGM * nN, gid = wgid / nig, fm = gid * WGM, gsz = (nM - fm) < WGM ? (nM - fm) : WGM;
        u.pm = fm + ((wgid % nig) % gsz); u.pn = (wgid % nig) / gsz; u.nt = ntf; return u;
    }
    __device__ __forceinline__ void a_ready(const Unit&) const {}
    __device__ __forceinline__ void done(const Unit&) const {}
};

struct TailOrder {
    StaticOrder base; int rounds, ntf, cc;
    __host__ __device__ void init(int N, int G_, int c_, int K_) { base.init(16384, N, G_, c_, K_); rounds = base.nwg / G_; ntf = K_ / BK; cc = c_; }
    __host__ __device__ __forceinline__ Unit get(int i) const {
        if (i < rounds) return base.get(i);
        Unit u; u.pm = 0; u.pn = 0; u.k0 = 0; u.nt = 0; u.sp = -1;
        if (i > rounds) return u;
        const int tile = cc >> 3, s = cc & 7; u.pm = 64 + (tile >> 3); u.pn = tile & 7; u.sp = s;
        const int b8 = ntf / 8;
        if (b8 & 1) { u.nt = (s & 1) ? b8 - 1 : b8 + 1; u.k0 = (s >> 1) * (2 * b8) + (s & 1) * (b8 + 1); }
        else { u.nt = b8; u.k0 = s * b8; }
        return u;
    }
    __device__ __forceinline__ void a_ready(const Unit&) const {}
    __device__ __forceinline__ void done(const Unit&) const {}
};

struct EpiF32 {
    static constexpr bool PERM = false, AFTER_DRAIN = false;
    bf16_t* Cb; int ldc; float* part;
    __device__ __forceinline__ void operator()(const f32x4 (&acc)[2][2][4][2], const Unit& u, int wr, int wc, int fr, int fq) const {
        const int row0 = u.pm * BM + wr * 64 + fr, col0 = u.pn * BM + wc * 32 + 4 * fq;
        if (u.sp >= 0) { float* C = part + (size_t)u.sp * ((size_t)1024 * ldc);
#pragma unroll
            for (int ai = 0; ai < 2; ++ai)
#pragma unroll
                for (int m = 0; m < 4; ++m) { float* rowp = C + (size_t)(row0 - 16384 + ai * HALF + m * 16) * ldc + col0;
#pragma unroll
                    for (int bj = 0; bj < 2; ++bj)
#pragma unroll
                        for (int n = 0; n < 2; ++n) *(f32x4*)(rowp + bj * HALF + n * 16) = acc[ai][bj][m][n]; }
        } else {
#pragma unroll
            for (int ai = 0; ai < 2; ++ai)
#pragma unroll
                for (int m = 0; m < 4; ++m) { bf16_t* rowp = Cb + (size_t)(row0 + ai * HALF + m * 16) * ldc + col0;
#pragma unroll
                    for (int bj = 0; bj < 2; ++bj)
#pragma unroll
                        for (int n = 0; n < 2; ++n) { const f32x4 v = acc[ai][bj][m][n]; *(u32x2*)(rowp + bj * HALF + n * 16) = (u32x2){pk2(v[0], v[1]), pk2(v[2], v[3])}; } }
        }
    }
};
struct EpiBf16 {
    static constexpr bool PERM = true, AFTER_DRAIN = false;
    bf16_t* O; int ldc;
    __device__ __forceinline__ void operator()(const f32x4 (&acc)[2][2][4][2], const Unit& u, int wr, int wc, int fr, int fq) const {
        const int row0 = u.pm * BM + wr * 64 + fr, col0 = u.pn * BM + wc * 32 + 8 * fq;
#pragma unroll
        for (int ai = 0; ai < 2; ++ai)
#pragma unroll
            for (int m = 0; m < 4; ++m) { bf16_t* rowp = O + (size_t)(row0 + ai * HALF + m * 16) * ldc + col0;
#pragma unroll
                for (int bj = 0; bj < 2; ++bj) { const f32x4 v0 = acc[ai][bj][m][0], v1 = acc[ai][bj][m][1];
                    u32x4 w; w.x = pk2(v0[0], v0[1]); w.y = pk2(v0[2], v0[3]); w.z = pk2(v1[0], v1[1]); w.w = pk2(v1[2], v1[3]);
                    *(u32x4*)(rowp + bj * HALF) = w; } }
    }
};
struct EpiSwiglu {
    static constexpr bool PERM = true, AFTER_DRAIN = false;
    bf16_t* O; int ldc;
    __device__ __forceinline__ void operator()(const f32x4 (&acc)[2][2][4][2], const Unit& u, int wr, int wc, int fr, int fq) const {
        const int row0 = u.pm * BM + wr * 64 + fr, col0 = u.pn * HALF + wc * 32 + 8 * fq;
#pragma unroll
        for (int ai = 0; ai < 2; ++ai)
#pragma unroll
            for (int m = 0; m < 4; ++m) { bf16_t* rowp = O + (size_t)(row0 + ai * HALF + m * 16) * ldc + col0;
                float r[8];
#pragma unroll
                for (int n = 0; n < 2; ++n)
#pragma unroll
                    for (int j = 0; j < 4; ++j) { const float g = acc[ai][0][m][n][j], up = acc[ai][1][m][n][j]; r[n * 4 + j] = g * __builtin_amdgcn_rcpf(1.0f + __expf(-g)) * up; }
                u32x4 w; w.x = pk2(r[0], r[1]); w.y = pk2(r[2], r[3]); w.z = pk2(r[4], r[5]); w.w = pk2(r[6], r[7]);
                *(u32x4*)rowp = w; }
    }
};
struct EpiMemKV {
    static constexpr bool PERM = false, AFTER_DRAIN = false;
    float* outK; float* outV; bf16_t* bK; bf16_t* bV;
    __device__ __forceinline__ void operator()(const f32x4 (&acc)[2][2][4][2], const Unit& u, int wr, int wc, int fr, int fq) const {
        const int row0 = u.pm * BM + wr * 64 + fr; int colt = u.pn * BM; float* of = outK; bf16_t* ob = bK;
        if (colt >= 512) { colt -= 512; of = outV; ob = bV; }
        const int col0 = colt + wc * 32 + 4 * fq;
#pragma unroll
        for (int ai = 0; ai < 2; ++ai)
#pragma unroll
            for (int m = 0; m < 4; ++m) { const size_t off = (size_t)(row0 + ai * HALF + m * 16) * 512 + col0;
#pragma unroll
                for (int bj = 0; bj < 2; ++bj)
#pragma unroll
                    for (int n = 0; n < 2; ++n) { const f32x4 v = acc[ai][bj][m][n]; *(f32x4*)(of + off + bj * HALF + n * 16) = v;
                        u32x2 w; w.x = pk2(v[0], v[1]); w.y = pk2(v[2], v[3]); *(u32x2*)(ob + off + bj * HALF + n * 16) = w; } }
    }
};

template <class Epi, class Sched, bool ALIGN_EPI = false, bool SP2 = false>
__device__ __forceinline__ void gemm_phase(PG8_LAS unsigned char* lds, const Gemm g, const Sched& S, const Epi& E) {
    const int tid = threadIdx.x, wid = __builtin_amdgcn_readfirstlane(tid >> 6), lane = tid & 63, wr = wid >> 2, wc = wid & 3, fr = lane & 15, fq = lane >> 4;
    const int K = g.K;
    unsigned voffA[2], voffB[2];
#pragma unroll
    for (int i = 0; i < 2; ++i) { int R, C; stage_rc(tid * 16 + i * 8192, R, C); const int Rb = Epi::PERM ? ((R & ~31) + perm32(R & 31)) : R;
        voffA[i] = (unsigned)(R * K + C) * 2u; voffB[i] = (unsigned)(Rb * K + C) * 2u; }
    const size_t kstep = (size_t)(BK * 2);
    const size_t hstep = (size_t)HALF * K * 2;
    const size_t tstep = 2 * hstep;
    const unsigned ldsw = (unsigned)wid * 1024u;
    const int aoff = lds_byte(wr * 64 + fr, fq * 8), boff = lds_byte(wc * 32 + fr, fq * 8);
#define PG8_SA(b, h) (((b) * 2 + (h)) * HTB)
#define PG8_SB(b, h) ((4 + (b) * 2 + (h)) * HTB)
#define PG8_STAGE(bufoff, gbase, voff) do { _Pragma("unroll") for (int _i = 0; _i < 2; ++_i) \
        __builtin_amdgcn_global_load_lds((const unsigned*)((const char*)(gbase) + (voff)[_i]), (PG8_LAS unsigned*)(lds + (bufoff) + ldsw + _i * 8192), 16, 0, 0); } while (0)
#define PG8_LDA(dst, b, h) do { _Pragma("unroll") for (int m = 0; m < 4; ++m) _Pragma("unroll") for (int k = 0; k < 2; ++k) dst[m][k] = *(const PG8_LAS bf16x8*)(lds + PG8_SA(b, h) + aoff + m * 2048 + k * 1024); } while (0)
#define PG8_LDB(dst, b, h) do { _Pragma("unroll") for (int n = 0; n < 2; ++n) _Pragma("unroll") for (int k = 0; k < 2; ++k) dst[n][k] = *(const PG8_LAS bf16x8*)(lds + PG8_SB(b, h) + boff + n * 2048 + k * 1024); } while (0)
#define PG8_MMA(ai, bj, At, Bt) do { __builtin_amdgcn_s_setprio(1); _Pragma("unroll") for (int m = 0; m < 4; ++m) _Pragma("unroll") for (int n = 0; n < 2; ++n) _Pragma("unroll") for (int k = 0; k < 2; ++k) \
        acc[ai][bj][m][n] = __builtin_amdgcn_mfma_f32_16x16x32_bf16(Bt[n][k], At[m][k], acc[ai][bj][m][n], 0, 0, 0); __builtin_amdgcn_s_setprio(0); } while (0)
#define PG8_WAIT_V(n) asm volatile("s_waitcnt vmcnt(" #n ")" ::: "memory")
#define PG8_WAIT_L(n) asm volatile("s_waitcnt lgkmcnt(" #n ")" ::: "memory")
#define PG8_BAR __builtin_amdgcn_s_barrier()
#define PG8_SCHED __builtin_amdgcn_sched_barrier(0)
    Unit cur = S.get(0), nxt; int ui = 0;
    if (cur.nt == 0) return;
    f32x4 acc[2][2][4][2];
#pragma unroll
    for (int a = 0; a < 2; ++a)
#pragma unroll
        for (int b = 0; b < 2; ++b)
#pragma unroll
            for (int m = 0; m < 4; ++m)
#pragma unroll
                for (int n = 0; n < 2; ++n) acc[a][b][m][n] = (f32x4){0.f, 0.f, 0.f, 0.f};
    bf16x8 At[4][2], B0[2][2], B1[2][2];
    const char* cA = (const char*)g.A + (size_t)cur.pm * tstep + (size_t)cur.k0 * kstep; const char* cB = (const char*)g.Bt + (size_t)cur.pn * tstep + (size_t)cur.k0 * kstep;
    S.a_ready(cur);
    if constexpr (SP2) {
        PG8_STAGE(PG8_SB(0, 0), cB, voffB); PG8_STAGE(PG8_SB(0, 1), cB + hstep, voffB); PG8_STAGE(PG8_SA(0, 0), cA, voffA); PG8_STAGE(PG8_SA(0, 1), cA + hstep, voffA);
        if (wr == 1) PG8_BAR;
        PG8_WAIT_V(2); PG8_BAR;
        PG8_STAGE(PG8_SB(1, 0), cB + kstep, voffB); PG8_STAGE(PG8_SA(1, 0), cA + kstep, voffA); PG8_STAGE(PG8_SB(1, 1), cB + hstep + kstep, voffB);
        PG8_WAIT_V(6); PG8_BAR;
    } else {
        PG8_STAGE(PG8_SB(0, 0), cB, voffB); PG8_STAGE(PG8_SA(0, 0), cA, voffA); PG8_STAGE(PG8_SB(0, 1), cB + hstep, voffB); PG8_STAGE(PG8_SA(0, 1), cA + hstep, voffA);
        if (wr == 1) PG8_BAR;
        PG8_WAIT_V(4); PG8_BAR;
        PG8_STAGE(PG8_SB(1, 0), cB + kstep, voffB); PG8_STAGE(PG8_SA(1, 0), cA + kstep, voffA); PG8_STAGE(PG8_SB(1, 1), cB + hstep + kstep, voffB);
        PG8_WAIT_V(6); PG8_BAR;
    }
    for (;;) {
        nxt = S.get(ui + 1); const bool has_next = nxt.nt != 0;
        const char* nA = has_next ? (const char*)g.A + (size_t)nxt.pm * tstep + (size_t)nxt.k0 * kstep : cA; const char* nB = has_next ? (const char*)g.Bt + (size_t)nxt.pn * tstep + (size_t)nxt.k0 * kstep : cB;
        const int nt = cur.nt;
        for (int t = 0; t < nt; t += 2) {
            const bool last = (t == nt - 2);
            const char* a1 = cA + (size_t)(t + 1) * kstep;
            const char* a2 = last ? nA : cA + (size_t)(t + 2) * kstep; const char* b2 = last ? nB : cB + (size_t)(t + 2) * kstep;
            const char* a3 = a2 + kstep; const char* b3 = b2 + kstep;
            if (last && has_next) S.a_ready(nxt);
            if constexpr (SP2) {
            PG8_LDB(B0, 0, 0); PG8_LDB(B1, 0, 1); PG8_SCHED; PG8_LDA(At, 0, 0); PG8_STAGE(PG8_SA(1, 1), a1 + hstep, voffA);
            PG8_WAIT_V(8); PG8_WAIT_L(0); PG8_BAR; PG8_MMA(0, 0, At, B0); PG8_MMA(0, 1, At, B1); PG8_BAR; PG8_SCHED;
            PG8_LDA(At, 0, 1); PG8_STAGE(PG8_SB(0, 0), b2, voffB); PG8_STAGE(PG8_SB(0, 1), b2 + hstep, voffB); PG8_STAGE(PG8_SA(0, 0), a2, voffA);
            PG8_WAIT_V(8); PG8_WAIT_L(0); PG8_BAR; PG8_MMA(1, 0, At, B0); PG8_MMA(1, 1, At, B1); PG8_BAR; PG8_SCHED;
            PG8_LDB(B0, 1, 0); PG8_LDB(B1, 1, 1); PG8_SCHED; PG8_LDA(At, 1, 0); PG8_STAGE(PG8_SA(0, 1), a2 + hstep, voffA);
            PG8_WAIT_V(8); PG8_WAIT_L(0); PG8_BAR; PG8_MMA(0, 0, At, B0); PG8_MMA(0, 1, At, B1); PG8_BAR; PG8_SCHED;
            PG8_LDA(At, 1, 1); PG8_STAGE(PG8_SB(1, 0), b3, voffB); PG8_STAGE(PG8_SB(1, 1), b3 + hstep, voffB); PG8_STAGE(PG8_SA(1, 0), a3, voffA);
            PG8_WAIT_V(8); PG8_WAIT_L(0); PG8_BAR; PG8_MMA(1, 0, At, B0); PG8_MMA(1, 1, At, B1); PG8_BAR; PG8_SCHED;
            } else {
            PG8_LDB(B0, 0, 0); PG8_SCHED; PG8_LDA(At, 0, 0); PG8_STAGE(PG8_SA(1, 1), a1 + hstep, voffA);
            PG8_WAIT_L(8); PG8_BAR; PG8_WAIT_L(0); PG8_MMA(0, 0, At, B0); PG8_BAR; PG8_SCHED;
            PG8_LDB(B1, 0, 1); PG8_STAGE(PG8_SB(0, 0), b2, voffB);
            PG8_BAR; PG8_WAIT_L(0); PG8_MMA(0, 1, At, B1); PG8_BAR;
            PG8_LDA(At, 0, 1); PG8_STAGE(PG8_SA(0, 0), a2, voffA);
            PG8_BAR; PG8_WAIT_L(0); PG8_MMA(1, 0, At, B0); PG8_BAR; PG8_SCHED;
            PG8_STAGE(PG8_SB(0, 1), b2 + hstep, voffB);
            PG8_WAIT_V(6); PG8_BAR; PG8_MMA(1, 1, At, B1); PG8_BAR;
            PG8_LDB(B0, 1, 0); PG8_SCHED; PG8_LDA(At, 1, 0); PG8_STAGE(PG8_SA(0, 1), a2 + hstep, voffA);
            PG8_WAIT_L(8); PG8_BAR; PG8_WAIT_L(0); PG8_MMA(0, 0, At, B0); PG8_BAR; PG8_SCHED;
            PG8_LDB(B1, 1, 1); PG8_STAGE(PG8_SB(1, 0), b3, voffB);
            PG8_BAR; PG8_WAIT_L(0); PG8_MMA(0, 1, At, B1); PG8_BAR;
            PG8_LDA(At, 1, 1); PG8_STAGE(PG8_SA(1, 0), a3, voffA);
            PG8_BAR; PG8_WAIT_L(0); PG8_MMA(1, 0, At, B0); PG8_BAR; PG8_SCHED;
            PG8_STAGE(PG8_SB(1, 1), b3 + hstep, voffB);
            PG8_WAIT_V(6); PG8_BAR; PG8_MMA(1, 1, At, B1); PG8_BAR;
            }
        }
        if constexpr (ALIGN_EPI) { if (wr == 0) PG8_BAR; }
        if constexpr (!Epi::AFTER_DRAIN) { E(acc, cur, wr, wc, fr, fq); S.done(cur); }
        if (!has_next) break;
#pragma unroll
        for (int a = 0; a < 2; ++a)
#pragma unroll
            for (int b = 0; b < 2; ++b)
#pragma unroll
                for (int m = 0; m < 4; ++m)
#pragma unroll
                    for (int n = 0; n < 2; ++n) acc[a][b][m][n] = (f32x4){0.f, 0.f, 0.f, 0.f};
        cur = nxt; cA = nA; cB = nB; ++ui;
        if constexpr (ALIGN_EPI) { if (wr == 1) PG8_BAR; }
    }
    PG8_WAIT_V(0);
    if constexpr (!ALIGN_EPI) { if (wr == 0) PG8_BAR; }
    PG8_BAR;
    if constexpr (Epi::AFTER_DRAIN) { E.fused(acc, cur, wr, wc, fr, fq, lds, wid, lane); S.done(cur); }
#undef PG8_SA
#undef PG8_SB
#undef PG8_STAGE
#undef PG8_LDA
#undef PG8_LDB
#undef PG8_MMA
#undef PG8_WAIT_V
#undef PG8_WAIT_L
#undef PG8_BAR
#undef PG8_SCHED
}
}

struct Params { const float* in[33]; float* out; unsigned char* ws; };

__device__ __forceinline__ void wt_load(f32x4 (&r)[8], const float* W, int N, int nblk, int item, int nitems, int lane) {
    if (item < nitems) { const int kb = item / nblk, nb = item % nblk; const float* src = W + (size_t)(64 * kb + (lane >> 3)) * N + 32 * nb + (lane & 7) * 4;
#pragma unroll
        for (int i = 0; i < 8; ++i) r[i] = *(const f32x4*)(src + (size_t)(8 * i) * N); }
}
__device__ __forceinline__ void wt_store(const f32x4 (&r)[8], int K, int nblk, bf16* WT, int mode, int row_off, LAS float* scr, int item, int nitems, int lane) {
    if (item < nitems) {
        const int kb = item / nblk, nb = item % nblk, k0 = 64 * kb, n0 = 32 * nb;
#pragma unroll
        for (int i = 0; i < 8; ++i) { LAS float* d = scr + (8 * i + (lane >> 3)) * 33 + (lane & 7) * 4; d[0] = r[i][0]; d[1] = r[i][1]; d[2] = r[i][2]; d[3] = r[i][3]; }
        asm volatile("s_waitcnt lgkmcnt(0)" ::: "memory");
        const int c = lane & 7;
#pragma unroll
        for (int j = 0; j < 4; ++j) { const int n = (lane >> 3) + 8 * j; const LAS float* s = scr + (8 * c) * 33 + n;
            u32x4 o; o.x = pk2(s[0 * 33], s[1 * 33]); o.y = pk2(s[2 * 33], s[3 * 33]); o.z = pk2(s[4 * 33], s[5 * 33]); o.w = pk2(s[6 * 33], s[7 * 33]);
            const int ng = n0 + n; int drow;
            if (mode == 0) drow = row_off + ng; else drow = (ng >> 7) * 256 + (mode == 2 ? 128 : 0) + (ng & 127);
            *(u32x4*)(WT + (size_t)drow * K + k0 + 8 * c) = o; }
        asm volatile("s_waitcnt lgkmcnt(0)" ::: "memory");
    }
}
__device__ __forceinline__ void wt_matrix(const float* W, int K, int N, bf16* WT, int mode, int row_off, LAS float* scr, int gw, int NGW, int lane) {
    const int nblk = N / 32, nitems = (K / 64) * nblk;
    f32x4 ra[8], rb[8], rc[8];
#pragma unroll
    for (int i = 0; i < 8; ++i) { ra[i] = (f32x4){0.f, 0.f, 0.f, 0.f}; rb[i] = ra[i]; rc[i] = ra[i]; }
    int item = gw;
    wt_load(ra, W, N, nblk, item, nitems, lane); wt_load(rb, W, N, nblk, item + NGW, nitems, lane);
    while (item < nitems) {
        wt_load(rc, W, N, nblk, item + 2 * NGW, nitems, lane); wt_store(ra, K, nblk, WT, mode, row_off, scr, item, nitems, lane);
        wt_load(ra, W, N, nblk, item + 3 * NGW, nitems, lane); wt_store(rb, K, nblk, WT, mode, row_off, scr, item + NGW, nitems, lane);
        wt_load(rb, W, N, nblk, item + 4 * NGW, nitems, lane); wt_store(rc, K, nblk, WT, mode, row_off, scr, item + 2 * NGW, nitems, lane);
        item += 3 * NGW;
    }
}

template <int XSRC>
__device__ __forceinline__ void nr_load_x(u32x4 (&raw)[8], const float* xa, const float* xb, int split, const bf16* xbf, int row, int lane) {
    if (XSRC == 0) { const float* xr = row < split ? xa + (size_t)row * DM : xb + (size_t)(row - split) * DM;
#pragma unroll
        for (int j = 0; j < 4; ++j) { raw[2 * j] = *(const u32x4*)(xr + j * 512 + lane * 8); raw[2 * j + 1] = *(const u32x4*)(xr + j * 512 + lane * 8 + 4); } }
    else {
#pragma unroll
        for (int j = 0; j < 4; ++j) raw[j] = *(const u32x4*)(xbf + (size_t)row * DM + j * 512 + lane * 8); }
}
__device__ __forceinline__ void nr_unpack(const u32x4 w, f32x4& a, f32x4& b) { a = (f32x4){bflo(w.x), bfhi(w.x), bflo(w.y), bfhi(w.y)}; b = (f32x4){bflo(w.z), bfhi(w.z), bflo(w.w), bfhi(w.w)}; }
template <int XSRC, bool HAS_F, bool HAS_NEXT, bool SPLIT, int XDST  >
__device__ __forceinline__ void norm_rows(const bf16* Fm, const float* part, const float* xa, const float* xb, int split, int nrows, const bf16* xin_bf, bf16* xout_bf, float* xout_f,
                                          float scale, const float* g_post, const float* g_next, bf16* hout, LAS unsigned char* lds, int tid, int gw, int NGW, int lane) {
    LAS float* gl = (LAS float*)lds;
    __syncthreads();
    { const int i = tid; if (HAS_F) *(LAS f32x4*)(gl + i * 4) = *(const f32x4*)(g_post + i * 4); if (HAS_NEXT) *(LAS f32x4*)(gl + 2048 + i * 4) = *(const f32x4*)(g_next + i * 4); }
    __syncthreads();
    int row = gw;
    u32x4 xr[8], fr_[4];
#pragma unroll
    for (int i = 0; i < 8; ++i) xr[i] = (u32x4){0u, 0u, 0u, 0u};
#pragma unroll
    for (int j = 0; j < 4; ++j) fr_[j] = (u32x4){0u, 0u, 0u, 0u};
    if (row < nrows) { nr_load_x<XSRC>(xr, xa, xb, split, xin_bf, row, lane);
        if (HAS_F && !(SPLIT && row >= MP)) {
#pragma unroll
            for (int j = 0; j < 4; ++j) fr_[j] = *(const u32x4*)(Fm + (size_t)row * DM + j * 512 + lane * 8); } }
    while (row < nrows) {
        const int nrow = row + NGW;
        u32x4 xn[8], fn[4];
#pragma unroll
        for (int i = 0; i < 8; ++i) xn[i] = (u32x4){0u, 0u, 0u, 0u};
#pragma unroll
        for (int j = 0; j < 4; ++j) fn[j] = (u32x4){0u, 0u, 0u, 0u};
        if (nrow < nrows) { nr_load_x<XSRC>(xn, xa, xb, split, xin_bf, nrow, lane);
            if (HAS_F && !(SPLIT && nrow >= MP)) {
#pragma unroll
                for (int j = 0; j < 4; ++j) fn[j] = *(const u32x4*)(Fm + (size_t)nrow * DM + j * 512 + lane * 8); } }
        f32x4 x[8];
        if (XSRC == 0) {
#pragma unroll
            for (int i = 0; i < 8; ++i) x[i] = __builtin_bit_cast(f32x4, xr[i]); }
        else {
#pragma unroll
            for (int j = 0; j < 4; ++j) nr_unpack(xr[j], x[2 * j], x[2 * j + 1]); }
        if (HAS_F) {
            f32x4 f[8];
            if (SPLIT && row >= MP) {
#pragma unroll
                for (int i = 0; i < 8; ++i) { const float* pr = part + (size_t)(row - MP) * DM + (i >> 1) * 512 + lane * 8 + (i & 1) * 4; f32x4 a = *(const f32x4*)pr;
#pragma unroll
                    for (int s = 1; s < 8; ++s) a = a + *(const f32x4*)(pr + (size_t)s * 1024 * DM);
                    f[i] = a; __builtin_amdgcn_sched_barrier(0); } }
            else {
#pragma unroll
                for (int j = 0; j < 4; ++j) nr_unpack(fr_[j], f[2 * j], f[2 * j + 1]); }
            float ss = 0.f;
#pragma unroll
            for (int i = 0; i < 8; ++i) ss += (f[i][0] * f[i][0] + f[i][1] * f[i][1]) + (f[i][2] * f[i][2] + f[i][3] * f[i][3]);
            const float rstd = rsqrtf(wave_sum(ss) * (1.0f / DM) + EPS) * scale;
#pragma unroll
            for (int i = 0; i < 8; ++i) { const f32x4 g = *(const LAS f32x4*)(gl + (i >> 1) * 512 + lane * 8 + (i & 1) * 4); x[i] = x[i] + f[i] * g * rstd; }
            if (XDST == 1) {
#pragma unroll
                for (int j = 0; j < 4; ++j) *(u32x4*)(xout_bf + (size_t)row * DM + j * 512 + lane * 8) = (u32x4){pk2(x[2 * j][0], x[2 * j][1]), pk2(x[2 * j][2], x[2 * j][3]), pk2(x[2 * j + 1][0], x[2 * j + 1][1]), pk2(x[2 * j + 1][2], x[2 * j + 1][3])}; }
            if (XDST == 2) {
#pragma unroll
                for (int i = 0; i < 8; ++i) *(f32x4*)(xout_f + (size_t)row * DM + (i >> 1) * 512 + lane * 8 + (i & 1) * 4) = x[i]; }
        }
        if (HAS_NEXT) {
            float ss = 0.f;
#pragma unroll
            for (int i = 0; i < 8; ++i) ss += (x[i][0] * x[i][0] + x[i][1] * x[i][1]) + (x[i][2] * x[i][2] + x[i][3] * x[i][3]);
            const float rstd = rsqrtf(wave_sum(ss) * (1.0f / DM) + EPS);
            f32x4 h[8];
#pragma unroll
            for (int i = 0; i < 8; ++i) { const f32x4 g = *(const LAS f32x4*)(gl + 2048 + (i >> 1) * 512 + lane * 8 + (i & 1) * 4); h[i] = x[i] * g * rstd; }
#pragma unroll
            for (int j = 0; j < 4; ++j) *(u32x4*)(hout + (size_t)row * DM + j * 512 + lane * 8) = (u32x4){pk2(h[2 * j][0], h[2 * j][1]), pk2(h[2 * j][2], h[2 * j][3]), pk2(h[2 * j + 1][0], h[2 * j + 1][1]), pk2(h[2 * j + 1][2], h[2 * j + 1][3])};
        }
#pragma unroll
        for (int i = 0; i < 8; ++i) xr[i] = xn[i];
#pragma unroll
        for (int j = 0; j < 4; ++j) fr_[j] = fn[j];
        row = nrow;
    }
    __syncthreads();
}

#define LDS_BARRIER() do { asm volatile("s_waitcnt lgkmcnt(0)" ::: "memory"); __builtin_amdgcn_s_barrier(); asm volatile("" ::: "memory"); } while (0)
#define MFMA16(a, b, c) __builtin_amdgcn_mfma_f32_16x16x32_bf16((a), (b), (c), 0, 0, 0)
__device__ __forceinline__ u32x4 ld8_bf16(const bf16* p) { return *(const u32x4*)p; }
__device__ __forceinline__ u32x4 ld8_f32(const float* p) { const f32x4 a = *(const f32x4*)p, b = *(const f32x4*)(p + 4); u32x4 w; w.x = pk2(a[0], a[1]); w.y = pk2(a[2], a[3]); w.z = pk2(b[0], b[1]); w.w = pk2(b[2], b[3]); return w; }
__device__ __forceinline__ void put_k(LAS unsigned char* Kl, int kstr, int kl, int dc, u32x4 v) { *(LAS u32x4*)(Kl + kl * kstr + dc * 16) = v; }
__device__ __forceinline__ void put_vt(LAS unsigned char* Vl, int vstr, int kl, int dc, u32x4 v) {
    LAS unsigned short* b = (LAS unsigned short*)(Vl + (dc * 8) * vstr + kl * 2); const int s2 = vstr / 2;
    b[0] = (unsigned short)(v.x & 0xffff); b[s2] = (unsigned short)(v.x >> 16); b[2 * s2] = (unsigned short)(v.y & 0xffff); b[3 * s2] = (unsigned short)(v.y >> 16);
    b[4 * s2] = (unsigned short)(v.z & 0xffff); b[5 * s2] = (unsigned short)(v.z >> 16); b[6 * s2] = (unsigned short)(v.w & 0xffff); b[7 * s2] = (unsigned short)(v.w >> 16);
}
template <int D, int NKT, bool WIN>
__device__ __forceinline__ void attn_group(const LAS unsigned char* Kl, int kstr, const LAS unsigned char* Vl, int vstr, const bf16x8 (&qf)[D / 32],
                                           int qpos, int kbase, float slope, float sink, float scale, int fr, int fq, f32x4 (&o)[D / 16]) {
    f32x4 s[NKT];
#pragma unroll
    for (int kt = 0; kt < NKT; ++kt) { s[kt] = (f32x4){0.f, 0.f, 0.f, 0.f};
#pragma unroll
        for (int ks = 0; ks < D / 32; ++ks) { const bf16x8 a = *(const LAS bf16x8*)(Kl + (kt * 16 + fr) * kstr + (ks * 32 + fq * 8) * 2); s[kt] = MFMA16(a, qf[ks], s[kt]); }
        if ((kt & (D == 64 ? 3 : 1)) == (D == 64 ? 3 : 1)) __builtin_amdgcn_sched_barrier(0); }
    float m = -1e30f;
#pragma unroll
    for (int kt = 0; kt < NKT; ++kt)
#pragma unroll
        for (int j = 0; j < 4; ++j) { float v = s[kt][j] * scale;
            if (WIN) { const int kpos = kbase + kt * 16 + fq * 4 + j, dist = qpos - kpos; const bool valid = (kpos >= 0) && (dist >= 0) && (dist < 128); v = valid ? v - slope * (float)dist : -1e30f; }
            s[kt][j] = v; m = fmaxf(m, v); }
    m = fmaxf(m, __shfl_xor(m, 16)); m = fmaxf(m, __shfl_xor(m, 32));
    if (WIN) m = fmaxf(m, sink);
    float sum = 0.f;
#pragma unroll
    for (int kt = 0; kt < NKT; ++kt)
#pragma unroll
        for (int j = 0; j < 4; ++j) { const float pe = __expf(s[kt][j] - m); s[kt][j] = pe; sum += pe; }
    sum += __shfl_xor(sum, 16); sum += __shfl_xor(sum, 32);
    if (WIN) sum += __expf(sink - m);
    const float inv = 1.0f / sum;
#pragma unroll
    for (int dt = 0; dt < D / 16; ++dt) o[dt] = (f32x4){0.f, 0.f, 0.f, 0.f};
#pragma unroll
    for (int kk = 0; kk < NKT / 2; ++kk) {
        u32x4 pw; pw.x = pk2(s[2 * kk][0], s[2 * kk][1]); pw.y = pk2(s[2 * kk][2], s[2 * kk][3]); pw.z = pk2(s[2 * kk + 1][0], s[2 * kk + 1][1]); pw.w = pk2(s[2 * kk + 1][2], s[2 * kk + 1][3]);
        const bf16x8 pf = __builtin_bit_cast(bf16x8, pw);
#pragma unroll
        for (int dt = 0; dt < D / 16; ++dt) {
            const u32x2 lo = *(const LAS u32x2*)(Vl + (dt * 16 + fr) * vstr + ((2 * kk) * 16 + fq * 4) * 2), hi = *(const LAS u32x2*)(Vl + (dt * 16 + fr) * vstr + ((2 * kk + 1) * 16 + fq * 4) * 2);
            u32x4 aw; aw.x = lo.x; aw.y = lo.y; aw.z = hi.x; aw.w = hi.y;
            o[dt] = MFMA16(__builtin_bit_cast(bf16x8, aw), pf, o[dt]); }
        __builtin_amdgcn_sched_barrier(0);
    }
#pragma unroll
    for (int dt = 0; dt < D / 16; ++dt) o[dt] = o[dt] * inv;
}

__device__ __forceinline__ void win_attn_prompt_unit(int unit, const bf16* Z, bf16* HB, const float* sinks, LAS unsigned char* lds, int tid, int wave, int lane) {
    constexpr int KSTR = 144, VSTR = 520; LAS unsigned char* Kl = lds; LAS unsigned char* Vl = lds + 256 * KSTR;
    const int kvh = unit & 3, n = (unit >> 2) & 31, b = unit >> 7; const int fr = lane & 15, fq = lane >> 4;
    const int pos0 = n * 128 - 128;
#pragma unroll
    for (int idx = tid; idx < 256 * 8; idx += 512) { const int kl = idx >> 3, dc = idx & 7; const int pos = pos0 + kl;
        u32x4 kv = (u32x4){0u, 0u, 0u, 0u}, vv = kv;
        if (pos >= 0) { const bf16* zr = Z + (size_t)(b * SEQ + pos) * NIN + kvh * 64 + dc * 8; kv = ld8_bf16(zr + ZKA); vv = ld8_bf16(zr + ZVA); }
        put_k(Kl, KSTR, kl, dc, kv); put_vt(Vl, VSTR, kl, dc, vv); }
    LDS_BARRIER();
    const int g = wave >> 1, hq = kvh * 4 + g; const float slope = exp2f(-0.5f * (float)(hq + 1)), sink = sinks[hq];
    bf16x8 qn[2];
#pragma unroll
    for (int ks = 0; ks < 2; ++ks) qn[ks] = __builtin_bit_cast(bf16x8, ld8_bf16(Z + ((size_t)b * SEQ + n * 128 + ((wave & 1) * 4) * 16 + fr) * NIN + ZQA + hq * 64 + ks * 32 + fq * 8));
#pragma unroll 1
    for (int i = 0; i < 4; ++i) { const int tl = ((wave & 1) * 4 + i) * 16 + fr; const size_t row = (size_t)b * SEQ + n * 128 + tl;
        bf16x8 qf[2]; qf[0] = qn[0]; qf[1] = qn[1];
        if (i < 3) {
#pragma unroll
            for (int ks = 0; ks < 2; ++ks) qn[ks] = __builtin_bit_cast(bf16x8, ld8_bf16(Z + (row + 16) * NIN + ZQA + hq * 64 + ks * 32 + fq * 8)); }
        f32x4 o[4];
        attn_group<64, 16, true>(Kl, KSTR, Vl, VSTR, qf, n * 128 + tl, pos0, slope, sink, 0.125f, fr, fq, o);
#pragma unroll
        for (int dt = 0; dt < 4; ++dt) { u32x2 w; w.x = pk2(o[dt][0], o[dt][1]); w.y = pk2(o[dt][2], o[dt][3]); *(u32x2*)(HB + row * DM + hq * 64 + dt * 16 + fq * 4) = w; } }
    LDS_BARRIER();
}
__device__ __forceinline__ void win_attn_sample_unit(int unit, const bf16* Z, const float* cK, const float* cV, bf16* HB, const float* sinks, LAS unsigned char* lds, int tid, int wave, int lane) {
    constexpr int KSTR = 144, VSTR = 520; LAS unsigned char* Kl = lds; LAS unsigned char* Vl = lds + 256 * KSTR;
    const int kvh = unit & 3, b = unit >> 2; const int fr = lane & 15, fq = lane >> 4;
#pragma unroll
    for (int idx = tid; idx < 160 * 8; idx += 512) { const int kl = idx >> 3, dc = idx & 7;
        u32x4 kv = (u32x4){0u, 0u, 0u, 0u}, vv = kv;
        if (kl < 128) { const size_t off = ((size_t)(b * 128 + kl) * 4 + kvh) * 64 + dc * 8; kv = ld8_f32(cK + off); vv = ld8_f32(cV + off); }
        else if (kl < 136) { const bf16* zr = Z + (size_t)(MP + b * 8 + (kl - 128)) * NIN + kvh * 64 + dc * 8; kv = ld8_bf16(zr + ZKA); vv = ld8_bf16(zr + ZVA); }
        put_k(Kl, KSTR, kl, dc, kv); put_vt(Vl, VSTR, kl, dc, vv); }
    LDS_BARRIER();
    if (wave < 2) { const int g = wave * 2 + (fr >> 3), hq = kvh * 4 + g, ti = fr & 7; const float slope = exp2f(-0.5f * (float)(hq + 1)), sink = sinks[hq];
        const size_t row = (size_t)MP + b * 8 + ti;
        bf16x8 qf[2];
#pragma unroll
        for (int ks = 0; ks < 2; ++ks) qf[ks] = __builtin_bit_cast(bf16x8, ld8_bf16(Z + row * NIN + ZQA + hq * 64 + ks * 32 + fq * 8));
        f32x4 o[4];
        attn_group<64, 10, true>(Kl, KSTR, Vl, VSTR, qf, PAST + ti, PAST - 128, slope, sink, 0.125f, fr, fq, o);
#pragma unroll
        for (int dt = 0; dt < 4; ++dt) { u32x2 w; w.x = pk2(o[dt][0], o[dt][1]); w.y = pk2(o[dt][2], o[dt][3]); *(u32x2*)(HB + row * DM + hq * 64 + dt * 16 + fq * 4) = w; } }
    LDS_BARRIER();
}
__device__ __forceinline__ void mem_attn_prompt_unit(int unit, const bf16* QM, const bf16* MK, const bf16* MV, bf16* OM, LAS unsigned char* lds, int tid, int wave, int lane) {
    constexpr int KSTR = 272, VSTR = 520; LAS unsigned char* Kl = lds; LAS unsigned char* Vl = lds + 256 * KSTR;
    const int qb = unit & 15, h = (unit >> 4) & 3, b = unit >> 6; const int fr = lane & 15, fq = lane >> 4;
#pragma unroll
    for (int idx = tid; idx < 256 * 16; idx += 512) { const int kl = idx >> 4, dc = idx & 15; const size_t off = (size_t)(b * 256 + kl) * 512 + h * 128 + dc * 8;
        put_k(Kl, KSTR, kl, dc, ld8_bf16(MK + off)); put_vt(Vl, VSTR, kl, dc, ld8_bf16(MV + off)); }
    LDS_BARRIER();
    bf16x8 qn[4];
#pragma unroll
    for (int ks = 0; ks < 4; ++ks) qn[ks] = __builtin_bit_cast(bf16x8, ld8_bf16(QM + ((size_t)b * SEQ + qb * 256 + (wave * 2) * 16 + fr) * 512 + h * 128 + ks * 32 + fq * 8));
#pragma unroll 1
    for (int i = 0; i < 2; ++i) { const size_t row = (size_t)b * SEQ + qb * 256 + (wave * 2 + i) * 16 + fr;
        bf16x8 qf[4];
#pragma unroll
        for (int ks = 0; ks < 4; ++ks) qf[ks] = qn[ks];
        if (i < 1) {
#pragma unroll
            for (int ks = 0; ks < 4; ++ks) qn[ks] = __builtin_bit_cast(bf16x8, ld8_bf16(QM + (row + 16) * 512 + h * 128 + ks * 32 + fq * 8)); }
        f32x4 o[8];
        attn_group<128, 16, false>(Kl, KSTR, Vl, VSTR, qf, 0, 0, 0.f, 0.f, 0.08838834764831845f, fr, fq, o);
#pragma unroll
        for (int dt = 0; dt < 8; ++dt) { u32x2 w; w.x = pk2(o[dt][0], o[dt][1]); w.y = pk2(o[dt][2], o[dt][3]); *(u32x2*)(OM + row * 512 + h * 128 + dt * 16 + fq * 4) = w; } }
    LDS_BARRIER();
}
__device__ __forceinline__ void mem_attn_sample_unit(int unit, const bf16* QM, const float* cK, const float* cV, bf16* OM, LAS unsigned char* lds, int tid, int wave, int lane) {
    constexpr int KSTR = 272, VSTR = 520; LAS unsigned char* Kl = lds; LAS unsigned char* Vl = lds + 256 * KSTR;
    const int h = unit & 3, b = unit >> 2; const int fr = lane & 15, fq = lane >> 4;
#pragma unroll 4
    for (int idx = tid; idx < 256 * 16; idx += 512) { const int kl = idx >> 4, dc = idx & 15; const size_t off = ((size_t)(b * 256 + kl) * 4 + h) * 128 + dc * 8;
        put_k(Kl, KSTR, kl, dc, ld8_f32(cK + off)); put_vt(Vl, VSTR, kl, dc, ld8_f32(cV + off)); }
    LDS_BARRIER();
    if (wave == 0) { const size_t row = (size_t)MP + b * 8 + (fr & 7);
        bf16x8 qf[4];
#pragma unroll
        for (int ks = 0; ks < 4; ++ks) qf[ks] = __builtin_bit_cast(bf16x8, ld8_bf16(QM + row * 512 + h * 128 + ks * 32 + fq * 8));
        f32x4 o[8];
        attn_group<128, 16, false>(Kl, KSTR, Vl, VSTR, qf, 0, 0, 0.f, 0.f, 0.08838834764831845f, fr, fq, o);
        if (fr < 8) {
#pragma unroll
            for (int dt = 0; dt < 8; ++dt) { u32x2 w; w.x = pk2(o[dt][0], o[dt][1]); w.y = pk2(o[dt][2], o[dt][3]); *(u32x2*)(OM + row * 512 + h * 128 + dt * 16 + fq * 4) = w; } } }
    LDS_BARRIER();
}

struct PassARaw { unsigned f[8], q[8], v[8]; };
__device__ __forceinline__ void hgrn_passA_load(PassARaw& R, int u, const bf16* Z, int tid) {
    const int c = u & 63, h = (u >> 6) & 7, b = u >> 9; const int chp = tid & 63, tq8 = tid >> 6;
    const bf16* zr = Z + ((size_t)b * SEQ + c * 64 + tq8 * 8) * NIN + h * 128 + chp * 2;
#pragma unroll
    for (int i = 0; i < 8; ++i) { R.f[i] = *(const unsigned*)(zr + (size_t)i * NIN + ZHF); R.q[i] = *(const unsigned*)(zr + (size_t)i * NIN + ZHQ); R.v[i] = *(const unsigned*)(zr + (size_t)i * NIN + ZHI); }
}
__device__ __forceinline__ void hgrn_passA4_sub(int u, int j, const PassARaw& R, const bf16* Z, const float* lbl, bf16* QH, bf16* OI, f32x4 (&uc)[8], float (&Lbase)[2], LAS unsigned char* lds, int tid, int wave, int lane) {
    constexpr int TOT = 0, QT = 4096, KT = QT + 64 * 272, KH = KT + 64 * 272, VT = KH + 128 * 144, AM = VT + 128 * 144, QL = AM + 64 * 144, UCT = QL + 64 * 272, DCL = UCT + 128 * 272;
    const int c = u & 63, h = (u >> 6) & 7, b = u >> 9; const int fr = lane & 15, fq = lane >> 4;
    const size_t r0 = (size_t)b * SEQ + c * 64;
    const int chp = tid & 63, tq8 = tid >> 6, c0 = chp * 2;
    {
        float lb[2], omlb[2];
#pragma unroll
        for (int cc = 0; cc < 2; ++cc) { const float l0 = lbl[h * 128 + c0 + cc], l1 = lbl[1024 + h * 128 + c0 + cc]; lb[cc] = 1.0f / (1.0f + __expf(l1 - l0)); omlb[cc] = 1.0f - lb[cc]; }
        float L[2][8], kk[2][8], qq[2][8]; float cum[2] = {0.f, 0.f};
#pragma unroll
        for (int i = 0; i < 8; ++i)
#pragma unroll
            for (int cc = 0; cc < 2; ++cc) { const float fraw = cc ? bfhi(R.f[i]) : bflo(R.f[i]), qraw = cc ? bfhi(R.q[i]) : bflo(R.q[i]);
                const float sg = sigmoidf_(fraw); cum[cc] += __logf(lb[cc] + omlb[cc] * sg); L[cc][i] = cum[cc]; kk[cc][i] = omlb[cc] * (1.0f - sg); qq[cc][i] = siluf_(qraw); }
        LAS float* tot = (LAS float*)(lds + TOT);
        *(LAS f32x2*)(tot + tq8 * 128 + c0) = (f32x2){cum[0], cum[1]};
        LDS_BARRIER();
        float pre[2] = {0.f, 0.f}, Lmid[2] = {0.f, 0.f}, Lend[2] = {0.f, 0.f};
#pragma unroll
        for (int g = 0; g < 8; ++g) { const f32x2 tv = *(const LAS f32x2*)(tot + g * 128 + c0);
#pragma unroll
            for (int cc = 0; cc < 2; ++cc) { pre[cc] += (g < tq8) ? tv[cc] : 0.f; Lmid[cc] += (g < 4) ? tv[cc] : 0.f; Lend[cc] += tv[cc]; } }
        unsigned kh[2][4], vp[2][4];
#pragma unroll
        for (int i = 0; i < 8; ++i) { const int t = tq8 * 8 + i; float qt[2], kt[2], qlv[2], qhv[2]; unsigned short khv[2];
#pragma unroll
            for (int cc = 0; cc < 2; ++cc) { const float Lt = pre[cc] + L[cc][i];
                qt[cc] = qq[cc][i] * __expf(fminf(Lt - Lmid[cc], 80.f)); kt[cc] = kk[cc][i] * __expf(fminf(Lmid[cc] - Lt, 80.f));
                qlv[cc] = qq[cc][i] * __expf(Lt); qhv[cc] = qq[cc][i] * __expf(Lbase[cc] + Lt); khv[cc] = f2bf(kk[cc][i] * __expf(Lend[cc] - Lt)); }
            *(LAS unsigned*)(lds + QT + t * 272 + c0 * 2) = pk2(qt[0], qt[1]); *(LAS unsigned*)(lds + KT + t * 272 + c0 * 2) = pk2(kt[0], kt[1]);
            *(LAS unsigned*)(lds + QL + t * 272 + c0 * 2) = pk2(qlv[0], qlv[1]);
            *(unsigned*)(QH + (r0 + t) * 1024 + h * 128 + c0) = pk2(qhv[0], qhv[1]);
            const unsigned v0 = R.v[i] & 0xffffu, v1 = R.v[i] >> 16;
            if (i & 1) { kh[0][i >> 1] |= (unsigned)khv[0] << 16; kh[1][i >> 1] |= (unsigned)khv[1] << 16; vp[0][i >> 1] |= v0 << 16; vp[1][i >> 1] |= v1 << 16; }
            else { kh[0][i >> 1] = khv[0]; kh[1][i >> 1] = khv[1]; vp[0][i >> 1] = v0; vp[1][i >> 1] = v1; } }
#pragma unroll
        for (int cc = 0; cc < 2; ++cc) { *(LAS u32x4*)(lds + KH + (c0 + cc) * 144 + tq8 * 16) = (u32x4){kh[cc][0], kh[cc][1], kh[cc][2], kh[cc][3]};
            *(LAS u32x4*)(lds + VT + (c0 + cc) * 144 + tq8 * 16) = (u32x4){vp[cc][0], vp[cc][1], vp[cc][2], vp[cc][3]}; }
        if (tq8 == 0) *(LAS f32x2*)(lds + DCL + c0 * 4) = (f32x2){__expf(Lend[0]), __expf(Lend[1])};
        Lbase[0] += Lend[0]; Lbase[1] += Lend[1];
    }
    LDS_BARRIER();
    {
        const int ti = wave >> 1;
#pragma unroll
        for (int q = 0; q < 2; ++q) { const int si = (wave & 1) * 2 + q; f32x4 a = (f32x4){0.f, 0.f, 0.f, 0.f};
#pragma unroll
            for (int ks = 0; ks < 4; ++ks) { const bf16x8 af = *(const LAS bf16x8*)(lds + QT + (ti * 16 + fr) * 272 + (ks * 32 + fq * 8) * 2), bfv = *(const LAS bf16x8*)(lds + KT + (si * 16 + fr) * 272 + (ks * 32 + fq * 8) * 2);
                a = MFMA16(af, bfv, a); }
#pragma unroll
            for (int jj = 0; jj < 4; ++jj) { const int t = ti * 16 + fq * 4 + jj, s = si * 16 + fr; const float v = (s <= t) ? a[jj] : 0.f; *(LAS unsigned short*)(lds + AM + t * 144 + s * 2) = f2bf(v); } }
    }
    LDS_BARRIER();
    {
        const int ti = wave >> 1; bf16x8 bm[2], ql[4];
#pragma unroll
        for (int kk = 0; kk < 2; ++kk) bm[kk] = *(const LAS bf16x8*)(lds + AM + (ti * 16 + fr) * 144 + (kk * 32 + fq * 8) * 2);
#pragma unroll
        for (int ks = 0; ks < 4; ++ks) ql[ks] = *(const LAS bf16x8*)(lds + QL + (ti * 16 + fr) * 272 + (ks * 32 + fq * 8) * 2);
#pragma unroll
        for (int q = 0; q < 4; ++q) { const int dvt = (wave & 1) * 4 + q; f32x4 o = (f32x4){0.f, 0.f, 0.f, 0.f};
#pragma unroll
            for (int kk = 0; kk < 2; ++kk) { const bf16x8 af = *(const LAS bf16x8*)(lds + VT + (dvt * 16 + fr) * 144 + (kk * 32 + fq * 8) * 2); o = MFMA16(af, bm[kk], o); }
            if (j > 0) {
#pragma unroll
                for (int ks = 0; ks < 4; ++ks) { const bf16x8 sf = *(const LAS bf16x8*)(lds + UCT + (dvt * 16 + fr) * 272 + (ks * 32 + fq * 8) * 2); o = MFMA16(sf, ql[ks], o); } }
            *(u32x2*)(OI + (r0 + ti * 16 + fr) * 1024 + h * 128 + dvt * 16 + fq * 4) = (u32x2){pk2(o[0], o[1]), pk2(o[2], o[3])}; }
        bf16x8 ka[2];
#pragma unroll
        for (int kk = 0; kk < 2; ++kk) ka[kk] = *(const LAS bf16x8*)(lds + KH + (wave * 16 + fr) * 144 + (kk * 32 + fq * 8) * 2);
        const f32x4 dvec = *(const LAS f32x4*)(lds + DCL + (wave * 16 + fq * 4) * 4);
#pragma unroll
        for (int dvt = 0; dvt < 8; ++dvt) { f32x4 uu = uc[dvt] * dvec;
#pragma unroll
            for (int kk = 0; kk < 2; ++kk) { const bf16x8 bv = *(const LAS bf16x8*)(lds + VT + (dvt * 16 + fr) * 144 + (kk * 32 + fq * 8) * 2); uu = MFMA16(ka[kk], bv, uu); }
            uc[dvt] = uu; }
    }
    LDS_BARRIER();
#pragma unroll
    for (int dvt = 0; dvt < 8; ++dvt) *(LAS u32x2*)(lds + UCT + (dvt * 16 + fr) * 272 + (wave * 16 + fq * 4) * 2) = (u32x2){pk2(uc[dvt][0], uc[dvt][1]), pk2(uc[dvt][2], uc[dvt][3])};
}
__device__ __forceinline__ void hgrn_passB(const bf16* UT, const float* DC, bf16* ST, float* PH, int gtid, int gthreads) {
    for (int e = gtid; e < 32 * 4096; e += gthreads) { const int seq = e >> 12, rem = e & 4095, dv = rem >> 5, dk = (rem & 31) * 4;
        u32x2 uw[16]; f32x4 Dv[16];
#pragma unroll
        for (int c = 0; c < 16; ++c) { const size_t u = (size_t)seq * 16 + c; uw[c] = *(const u32x2*)(UT + u * 16384 + dv * 128 + dk); Dv[c] = *(const f32x4*)(DC + u * 128 + dk); }
        f32x4 S = (f32x4){0.f, 0.f, 0.f, 0.f};
#pragma unroll
        for (int c = 0; c < 16; ++c) { const size_t u = (size_t)seq * 16 + c;
            const f32x4 U = (f32x4){bflo(uw[c].x), bfhi(uw[c].x), bflo(uw[c].y), bfhi(uw[c].y)};
            u32x2 w; w.x = pk2(S[0], S[1]); w.y = pk2(S[2], S[3]); *(u32x2*)(ST + u * 16384 + dv * 128 + dk) = w;
            S = Dv[c] * S + U; }
#pragma unroll
        for (int j = 0; j < 4; ++j) PH[(size_t)seq * 16384 + (dk + j) * 128 + dv] = S[j];
    }
}
__device__ __forceinline__ void hgrn_passC_unit(int u2, const bf16* QH, const bf16* ST, const bf16* OI, const bf16* Z, const float* gh, bf16* HB, int wave, int lane) {
    const int cu = u2 & 31, h = (u2 >> 5) & 7, b = u2 >> 8; const int fr = lane & 15, fq = lane >> 4;
    const int c = 2 * cu + (wave >> 2), ti = wave & 3; const size_t us = (size_t)(b * 8 + h) * 16 + (c >> 2); const size_t row = (size_t)b * SEQ + c * 64 + ti * 16 + fr;
    bf16x8 qf[4]; u32x2 ow[8], gwv[8];
#pragma unroll
    for (int ks = 0; ks < 4; ++ks) qf[ks] = __builtin_bit_cast(bf16x8, ld8_bf16(QH + row * 1024 + h * 128 + ks * 32 + fq * 8));
#pragma unroll
    for (int dvt = 0; dvt < 8; ++dvt) { ow[dvt] = *(const u32x2*)(OI + row * 1024 + h * 128 + dvt * 16 + fq * 4); gwv[dvt] = *(const u32x2*)(Z + row * NIN + ZHG + h * 128 + dvt * 16 + fq * 4); }
    u32x4 sfr[32];
#pragma unroll
    for (int dvt = 0; dvt < 8; ++dvt)
#pragma unroll
        for (int ks = 0; ks < 4; ++ks) sfr[dvt * 4 + ks] = ld8_bf16(ST + us * 16384 + (dvt * 16 + fr) * 128 + ks * 32 + fq * 8);
    __builtin_amdgcn_sched_barrier(0);
    f32x4 o[8]; float ss = 0.f;
#pragma unroll
    for (int dvt = 0; dvt < 8; ++dvt) { o[dvt] = (f32x4){bflo(ow[dvt].x), bfhi(ow[dvt].x), bflo(ow[dvt].y), bfhi(ow[dvt].y)};
#pragma unroll
        for (int ks = 0; ks < 4; ++ks) o[dvt] = MFMA16(__builtin_bit_cast(bf16x8, sfr[dvt * 4 + ks]), qf[ks], o[dvt]);
        ss += (o[dvt][0] * o[dvt][0] + o[dvt][1] * o[dvt][1]) + (o[dvt][2] * o[dvt][2] + o[dvt][3] * o[dvt][3]); }
    ss += __shfl_xor(ss, 16); ss += __shfl_xor(ss, 32);
    const float rstd = rsqrtf(ss * (1.0f / 128.0f) + EPS);
#pragma unroll
    for (int dvt = 0; dvt < 8; ++dvt) { const f32x4 g = *(const f32x4*)(gh + dvt * 16 + fq * 4);
        const float g0 = bflo(gwv[dvt].x), g1 = bfhi(gwv[dvt].x), g2 = bflo(gwv[dvt].y), g3 = bfhi(gwv[dvt].y);
        const float r0 = o[dvt][0] * rstd * g[0] * siluf_(g0), r1 = o[dvt][1] * rstd * g[1] * siluf_(g1), r2 = o[dvt][2] * rstd * g[2] * siluf_(g2), r3 = o[dvt][3] * rstd * g[3] * siluf_(g3);
        *(u32x2*)(HB + row * DM + 1024 + h * 128 + dvt * 16 + fq * 4) = (u32x2){pk2(r0, r1), pk2(r2, r3)}; }
}
__device__ __forceinline__ void hgrn_sample_unit(int unit, const bf16* Z, const float* lbl, const float* gh, const float* S0, float* S1, bf16* HB, LAS unsigned char* lds, int tid) {
    LAS float* Fl = (LAS float*)lds; LAS float* Kk = Fl + 1024; LAS float* Qq = Fl + 2048; LAS float* Vv = Fl + 3072; LAS float* red = Fl + 4096;
    const int h = unit & 7, b = unit >> 3; const size_t r0 = (size_t)MP + b * 8;
    const int dv4 = tid & 31, dkg = tid >> 5; const size_t sb = (size_t)unit * 16384;
    f32x4 S[8], op[8];
#pragma unroll
    for (int i = 0; i < 8; ++i) S[i] = *(const f32x4*)(S0 + sb + (dkg * 8 + i) * 128 + dv4 * 4);
    if (tid < 128) { const int ch = tid; const float l0 = lbl[h * 128 + ch], l1 = lbl[1024 + h * 128 + ch]; const float lb = 1.0f / (1.0f + __expf(l1 - l0)), omlb = 1.0f - lb;
#pragma unroll
        for (int t = 0; t < 8; ++t) { const bf16* zr = Z + (r0 + t) * NIN + h * 128 + ch; const float fraw = bf2f(zr[ZHF]), qraw = bf2f(zr[ZHQ]); const float sg = sigmoidf_(fraw);
            Fl[t * 128 + ch] = lb + omlb * sg; Kk[t * 128 + ch] = omlb * (1.0f - sg); Qq[t * 128 + ch] = siluf_(qraw); } }
    else if (tid < 256) { const int ch = tid - 128;
#pragma unroll
        for (int t = 0; t < 8; ++t) Vv[t * 128 + ch] = bf2f(Z[(r0 + t) * NIN + ZHI + h * 128 + ch]); }
    LDS_BARRIER();
#pragma unroll
    for (int t = 0; t < 8; ++t) { const f32x4 v = *(const LAS f32x4*)(Vv + t * 128 + dv4 * 4); f32x4 acc = (f32x4){0.f, 0.f, 0.f, 0.f};
#pragma unroll
        for (int i = 0; i < 8; ++i) { const int dk = dkg * 8 + i; const float f = Fl[t * 128 + dk], k = Kk[t * 128 + dk], q = Qq[t * 128 + dk]; S[i] = S[i] * f + v * k; acc = acc + S[i] * q; }
        op[t] = acc; }
#pragma unroll
    for (int i = 0; i < 8; ++i) *(f32x4*)(S1 + sb + (dkg * 8 + i) * 128 + dv4 * 4) = S[i];
#pragma unroll
    for (int t = 0; t < 8; ++t) *(LAS f32x4*)(red + (dkg * 8 + t) * 128 + dv4 * 4) = op[t];
    LDS_BARRIER();
    {   const int t = tid >> 6, ln = tid & 63; float s0 = 0.f, s1 = 0.f;
#pragma unroll
        for (int g = 0; g < 16; ++g) { s0 += red[(g * 8 + t) * 128 + ln]; s1 += red[(g * 8 + t) * 128 + 64 + ln]; }
        const float rstd = rsqrtf(wave_sum(s0 * s0 + s1 * s1) * (1.0f / 128.0f) + EPS);
        const bf16* zg = Z + (r0 + t) * NIN + ZHG + h * 128; bf16* ho = HB + (r0 + t) * DM + 1024 + h * 128;
        ho[ln] = f2bf(s0 * rstd * gh[ln] * siluf_(bf2f(zg[ln]))); ho[64 + ln] = f2bf(s1 * rstd * gh[64 + ln] * siluf_(bf2f(zg[64 + ln]))); }
    LDS_BARRIER();
}
__device__ __forceinline__ void attn_norm_rows(bf16* HB, const float* ga, int gw, int NGW, int lane) {
    float gav[16];
#pragma unroll
    for (int i = 0; i < 8; ++i) { gav[i] = ga[lane * 8 + i]; gav[8 + i] = ga[512 + lane * 8 + i]; }
    int row = gw;
    u32x4 c0 = (u32x4){0u, 0u, 0u, 0u}, c1 = c0, n0 = c0, n1 = c0;
    if (row < MT) { const bf16* hr = HB + (size_t)row * DM; c0 = *(const u32x4*)(hr + lane * 8); c1 = *(const u32x4*)(hr + 512 + lane * 8); }
    while (row < MT) {
        const int nrow = row + NGW;
        if (nrow < MT) { const bf16* hr = HB + (size_t)nrow * DM; n0 = *(const u32x4*)(hr + lane * 8); n1 = *(const u32x4*)(hr + 512 + lane * 8); }
        bf16* hr = HB + (size_t)row * DM;
        float v[16];
#pragma unroll
        for (int i = 0; i < 4; ++i) { v[2 * i] = bflo(c0[i]); v[2 * i + 1] = bfhi(c0[i]); v[8 + 2 * i] = bflo(c1[i]); v[8 + 2 * i + 1] = bfhi(c1[i]); }
        float ss = 0.f;
#pragma unroll
        for (int i = 0; i < 16; ++i) ss += v[i] * v[i];
        const float rstd = rsqrtf(wave_sum(ss) * (1.0f / 1024.0f) + EPS);
#pragma unroll
        for (int i = 0; i < 16; ++i) v[i] *= rstd * gav[i];
        *(u32x4*)(hr + lane * 8) = (u32x4){pk2(v[0], v[1]), pk2(v[2], v[3]), pk2(v[4], v[5]), pk2(v[6], v[7])};
        *(u32x4*)(hr + 512 + lane * 8) = (u32x4){pk2(v[8], v[9]), pk2(v[10], v[11]), pk2(v[12], v[13]), pk2(v[14], v[15])};
        c0 = n0; c1 = n1; row = nrow;
    }
}
__device__ __forceinline__ void win_outputs(const bf16* Z, const float* cK, const float* cV, float* out, int gtid, int gthreads) {
    for (int e = gtid; e < 2 * 4 * 128 * 64; e += gthreads) { const int which = e >> 15, r = e & 32767, c4 = (r & 63) * 4, t = (r >> 6) & 127, b = r >> 13;
        const bf16* z = Z + (size_t)(b * SEQ + SEQ - 128 + t) * NIN + (which ? ZVA : ZKA) + c4; const u32x2 w = *(const u32x2*)z;
        *(f32x4*)(out + (which ? O_PWV : O_PWK) + ((size_t)(b * 128 + t) * 256 + c4)) = (f32x4){bflo(w.x), bfhi(w.x), bflo(w.y), bfhi(w.y)}; }
    for (int e = gtid; e < 2 * 128 * 8 * 64; e += gthreads) { const int which = e >> 16, r = e & 65535, c4 = (r & 63) * 4, t = (r >> 6) & 7, b = r >> 9;
        const bf16* z = Z + (size_t)(MP + b * 8 + t) * NIN + (which ? ZVA : ZKA) + c4; const u32x2 w = *(const u32x2*)z;
        *(f32x4*)(out + (which ? O_SWV : O_SWK) + ((size_t)(b * 128 + 120 + t) * 256 + c4)) = (f32x4){bflo(w.x), bfhi(w.x), bflo(w.y), bfhi(w.y)}; }
}
__device__ __forceinline__ void win_cache_copy(const float* cK, const float* cV, float* out, int gtid, int gthreads) {
    constexpr int BLK = 120 * 64, TOT = 2 * 128 * BLK;
    for (int e0 = gtid; e0 < TOT; e0 += 8 * gthreads) { f32x4 v[8];
#pragma unroll
        for (int k = 0; k < 8; ++k) { const int e = e0 + k * gthreads; if (e < TOT) { const int wb = e / BLK, i = e - wb * BLK, which = wb >> 7, b = wb & 127; v[k] = *(const f32x4*)((which ? cV : cK) + (size_t)(b * 128 + 8) * 256 + (size_t)i * 4); } }
#pragma unroll
        for (int k = 0; k < 8; ++k) { const int e = e0 + k * gthreads; if (e < TOT) { const int wb = e / BLK, i = e - wb * BLK, which = wb >> 7, b = wb & 127; *(f32x4*)(out + (which ? O_SWV : O_SWK) + (size_t)(b * 128) * 256 + (size_t)i * 4) = v[k]; } } }
}

#define RLX_AGENT __ATOMIC_RELAXED, __HIP_MEMORY_SCOPE_AGENT
#define XB_TMO      128
#define XB_XCNT(j)  (256  + 64 * (j))
#define XB_XSUB(j)  (1280 + 64 * (j))
#define XB_XGEN(j)  (2304 + 64 * (j))
#define XB_TOP      3328
#define XB_TOPGEN   3392
#define XCD_BAR_WORDS 3456
#define XB_SPIN_CAP (1u << 18)

__device__ __forceinline__ unsigned xb_ld(unsigned* p)              { return __hip_atomic_load(p, __ATOMIC_RELAXED, __HIP_MEMORY_SCOPE_AGENT); }
__device__ __forceinline__ unsigned xb_add(unsigned* p, unsigned v) { return __hip_atomic_fetch_add(p, v, __ATOMIC_RELAXED, __HIP_MEMORY_SCOPE_AGENT); }
__device__ __forceinline__ unsigned xb_xcc_id() { return (unsigned)__builtin_amdgcn_s_getreg((3 << 11) | 20) & 0xFu; }
#define XB_SPIN(cond, bar) do { unsigned _sp = 0; while (cond) { __builtin_amdgcn_s_sleep(1); \
    if ((++_sp & 255u) == 0u) { if (xb_ld(&(bar)[XB_TMO])) break; if (_sp > XB_SPIN_CAP) { atomicAdd(&(bar)[XB_TMO], 1u); break; } } } } while (0)

struct XcdBarrier {
    unsigned* bar; unsigned x;
    volatile LAS unsigned* st;
};

__device__ __forceinline__ XcdBarrier xcd_barrier_post(unsigned* bar, volatile LAS unsigned* st) {
    XcdBarrier b; b.bar = bar; b.x = xb_xcc_id(); b.st = st;
    if (threadIdx.x == 0) (void)xb_add(&bar[XB_XCNT(b.x)], 1u);
    return b;
}
__device__ __forceinline__ void xcd_barrier_complete(unsigned* bar, unsigned x, unsigned& nloc, unsigned& nx) {
    const unsigned G = gridDim.x * gridDim.y * gridDim.z;
    unsigned sum, cnt, mine, sp = 0u;
    for (;;) {
        sum = 0u; cnt = 0u; mine = 0u;
#pragma unroll
        for (unsigned j = 0; j < 16; ++j) { const unsigned c = xb_ld(&bar[XB_XCNT(j)]); sum += c; cnt += (c > 0u) ? 1u : 0u; mine = (j == x) ? c : mine; }
        if (sum == G) break;
        __builtin_amdgcn_s_sleep(1);
        if ((++sp & 255u) == 0u) { if (xb_ld(&bar[XB_TMO])) break; if (sp > XB_SPIN_CAP) { atomicAdd(&bar[XB_TMO], 1u); break; } }
    }
    nloc = mine > 0u ? mine : 1u; nx = cnt > 0u ? cnt : 1u;
}

__device__ __forceinline__ void xcd_barrier(const XcdBarrier& b) {
    asm volatile("s_waitcnt vmcnt(0)" ::: "memory");
    __syncthreads();
    if (threadIdx.x == 0) {
        unsigned* bar = b.bar;
        __builtin_amdgcn_s_waitcnt(0);
        unsigned nloc = b.st[0], nx = b.st[1];
        if (nloc == 0u) { xcd_barrier_complete(bar, b.x, nloc, nx); b.st[0] = nloc; b.st[1] = nx; }
        const unsigned old = xb_add(&bar[XB_XSUB(b.x)], 1u);
        const unsigned gen = old / nloc;
        if (old + 1u == (gen + 1u) * nloc) {
            __builtin_amdgcn_fence(__ATOMIC_RELEASE, "agent");
            asm volatile("s_waitcnt vmcnt(0)" ::: "memory");
            const unsigned og = xb_add(&bar[XB_TOP], 1u);
            const unsigned tg = og / nx;
            if (og + 1u == (tg + 1u) * nx) xb_add(&bar[XB_TOPGEN], 1u);
            else XB_SPIN(xb_ld(&bar[XB_TOPGEN]) == tg, bar);
            __builtin_amdgcn_fence(__ATOMIC_ACQUIRE, "agent");
            xb_add(&bar[XB_XGEN(b.x)], 1u);
            asm volatile("s_waitcnt vmcnt(0)" ::: "memory");
        } else {
            XB_SPIN(xb_ld(&bar[XB_XGEN(b.x)]) == gen, bar);
            __builtin_amdgcn_fence(__ATOMIC_ACQUIRE, "agent");
            asm volatile("s_waitcnt vmcnt(0)" ::: "memory");
        }
    }
    __syncthreads();
}

__global__ void __launch_bounds__(512, 2) mega_fwd(Params p) {
    extern __shared__ __attribute__((aligned(16))) unsigned char lds_raw[];
    cg::grid_group grid = cg::this_grid();
    LAS unsigned char* lds = (LAS unsigned char*)lds_raw;
    const int tid = threadIdx.x, lane = tid & 63, wave = __builtin_amdgcn_readfirstlane(tid >> 6);
    const int G = gridDim.x, bx = blockIdx.x, gw = bx * 8 + wave, NGW = G * 8, gtid = bx * 512 + tid, gthreads = G * 512;
    unsigned char* ws = p.ws; float* out = p.out;
    bf16* W_GU = (bf16*)(ws + WS_WGU); bf16* W_D = (bf16*)(ws + WS_WD); bf16* W_IN = (bf16*)(ws + WS_WIN); bf16* W_OUT = (bf16*)(ws + WS_WOUT);
    bf16* W_MQ = (bf16*)(ws + WS_WMQ); bf16* W_MKV = (bf16*)(ws + WS_WMKV); bf16* W_MO = (bf16*)(ws + WS_WMO); bf16* MEMN = (bf16*)(ws + WS_MEMN);
    bf16* MK = (bf16*)(ws + WS_MK); bf16* MV = (bf16*)(ws + WS_MV); float* DC = (float*)(ws + WS_DC); bf16* HB = (bf16*)(ws + WS_HBUF);
    bf16* ACT = (bf16*)(ws + WS_ACT); bf16* Z = ACT; bf16* Fm = (bf16*)(ws + WS_F); bf16* UT = (bf16*)(ws + WS_F);     bf16* OI = (bf16*)(ws + WS_OI + 64 * MiB - 32 * MiB); float* PART = (float*)(ws + WS_OI);
    bf16* QH = (bf16*)(ws + WS_QH); bf16* ST = (bf16*)(ws + WS_ST); bf16* QM = (bf16*)(ws + WS_QMEM); bf16* OM = (bf16*)(ws + WS_OMEM);
    float* X = out + O_Y;
    bf16* XB = (bf16*)(ws + WS_XB);
    LAS float* scr = (LAS float*)(lds + wave * 8448);
    volatile LAS unsigned* bst = (volatile LAS unsigned*)(lds + LDS_BYTES - 64);
    if (tid < 16) bst[tid] = 0u;
    __syncthreads();
    XcdBarrier xbar = xcd_barrier_post((unsigned*)(ws + WS_BAR), bst);
#define GSYNC() xcd_barrier(xbar)

    if (PHMASK & (1u << 0)) {
    wt_matrix(p.in[10], DM, DFF, W_GU, 1, 0, scr, gw, NGW, lane);
    wt_matrix(p.in[11], DM, DFF, W_GU, 2, 0, scr, gw, NGW, lane);
    norm_rows<0, false, true, false, 0>(nullptr, nullptr, p.in[0], p.in[1], MP, MT, nullptr, nullptr, nullptr, 0.f, nullptr, p.in[8], HB, lds, tid, gw, NGW, lane);
    norm_rows<0, false, true, false, 0>(nullptr, nullptr, p.in[2], p.in[2], 1024, 1024, nullptr, nullptr, nullptr, 0.f, nullptr, p.in[23], MEMN, lds, tid, gw, NGW, lane);
    }
    GSYNC();
    if (PHMASK & (1u << 1)) {
    { pg8::Gemm g{HB, W_GU, MT, 2 * DFF, DM}; pg8::StaticOrder S; S.init(MT, 2 * DFF, G, bx, DM); pg8::EpiSwiglu E{ACT, DFF};
      pg8::gemm_phase<pg8::EpiSwiglu, pg8::StaticOrder, true, true>(lds, g, S, E); }
    if (G == 256 && bx >= 176) {
        const int gw2 = (bx - 176) * 8 + wave, ngw2 = 80 * 8;
        wt_matrix(p.in[12], DFF, DM, W_D, 0, 0, scr, gw2, ngw2, lane);
        wt_matrix(p.in[15], DM, NIN, W_IN, 0, 0, scr, gw2, ngw2, lane); }
    else if (G != 256) { wt_matrix(p.in[12], DFF, DM, W_D, 0, 0, scr, gw, NGW, lane); wt_matrix(p.in[15], DM, NIN, W_IN, 0, 0, scr, gw, NGW, lane); }
    }
    GSYNC();
    if (PHMASK & (1u << 2)) {
    { pg8::Gemm g{ACT, W_D, MT, DM, DFF}; pg8::TailOrder S; S.init(DM, G, bx, DFF); pg8::EpiF32 E{Fm, DM, PART};
      pg8::gemm_phase<pg8::EpiF32, pg8::TailOrder, true, true>(lds, g, S, E); }
    }
    GSYNC();
    if (PHMASK & (1u << 3)) {
    norm_rows<0, true, true, true, 1>(Fm, PART, p.in[0], p.in[1], MP, MT, nullptr, XB, nullptr, 0.5f, p.in[9], p.in[13], HB, lds, tid, gw, NGW, lane);
    }
    GSYNC();
    if (PHMASK & (1u << 4)) {
    { pg8::Gemm g{HB, W_IN, MT, NIN, DM}; pg8::StaticOrder S; S.init(MT, NIN, G, bx, DM); pg8::EpiBf16 E{Z, NIN};
      pg8::gemm_phase<pg8::EpiBf16, pg8::StaticOrder, true, true>(lds, g, S, E); }
    { const bool tail = (G == 256 && bx >= 216); const int gw2 = tail ? (bx - 216) * 8 + wave : gw, ngw2 = tail ? 40 * 8 : NGW;
      if (tail || G != 256) {
        wt_matrix(p.in[20], DM, DM, W_OUT, 0, 0, scr, gw2, ngw2, lane);
        wt_matrix(p.in[24], DM, 512, W_MQ, 0, 0, scr, gw2, ngw2, lane);
        wt_matrix(p.in[25], DM, 512, W_MKV, 0, 0, scr, gw2, ngw2, lane);
        wt_matrix(p.in[26], DM, 512, W_MKV, 0, 512, scr, gw2, ngw2, lane);
        wt_matrix(p.in[27], 512, DM, W_MO, 0, 0, scr, gw2, ngw2, lane); } }
    }
    GSYNC();
    if (PHMASK & (1u << 5)) {
    { PassARaw Rc, Rn; f32x4 uc[8]; float Lbase[2] = {0.f, 0.f};
#pragma unroll
      for (int i = 0; i < 8; ++i) uc[i] = (f32x4){0.f, 0.f, 0.f, 0.f};
      int U = bx, j = 0;
      if (U < 512) hgrn_passA_load(Rc, (U >> 4) * 64 + (U & 15) * 4, Z, tid);
      while (U < 512) {
          int Un = U, jn = j + 1; if (jn == 4) { jn = 0; Un = U + G; }
          if (Un < 512) hgrn_passA_load(Rn, (Un >> 4) * 64 + (Un & 15) * 4 + jn, Z, tid);
          if (j == 0) { Lbase[0] = 0.f; Lbase[1] = 0.f;
#pragma unroll
              for (int i = 0; i < 8; ++i) uc[i] = (f32x4){0.f, 0.f, 0.f, 0.f}; }
          hgrn_passA4_sub((U >> 4) * 64 + (U & 15) * 4 + j, j, Rc, Z, p.in[17], QH, OI, uc, Lbase, lds, tid, wave, lane);
          if (j == 3) { const int fr = lane & 15, fq = lane >> 4;
#pragma unroll
              for (int dvt = 0; dvt < 8; ++dvt) *(u32x2*)(UT + (size_t)U * 16384 + (dvt * 16 + fr) * 128 + wave * 16 + fq * 4) = (u32x2){pk2(uc[dvt][0], uc[dvt][1]), pk2(uc[dvt][2], uc[dvt][3])};
              if (tid < 64) { DC[(size_t)U * 128 + 2 * tid] = __expf(Lbase[0]); DC[(size_t)U * 128 + 2 * tid + 1] = __expf(Lbase[1]); } }
          Rc = Rn; U = Un; j = jn; }
      __syncthreads(); }
    for (int u = bx; u < 512; u += G) win_attn_prompt_unit(u, Z, HB, p.in[16], lds, tid, wave, lane);
    for (int u = bx; u < 512; u += G) win_attn_sample_unit(u, Z, p.in[3], p.in[4], HB, p.in[16], lds, tid, wave, lane);
    for (int u = bx; u < 1024; u += G) hgrn_sample_unit(u, Z, p.in[17], p.in[19], p.in[5], out + O_SH, HB, lds, tid);
    __syncthreads();
    win_outputs(Z, p.in[3], p.in[4], out, gtid, gthreads);
    }
    GSYNC();
    if (PHMASK & (1u << 6)) {
    hgrn_passB(UT, DC, ST, out + O_PH, gtid, gthreads);
    }
    GSYNC();
    if (PHMASK & (1u << 7)) {
    for (int u = bx; u < 1024; u += G) hgrn_passC_unit(u, QH, ST, OI, Z, p.in[19], HB, wave, lane);
    attn_norm_rows(HB, p.in[18], gw, NGW, lane);
    }
    GSYNC();
    if (PHMASK & (1u << 9)) {
    { pg8::Gemm g{HB, W_OUT, MT, DM, DM}; pg8::TailOrder S; S.init(DM, G, bx, DM); pg8::EpiF32 E{Fm, DM, PART};
      pg8::gemm_phase<pg8::EpiF32, pg8::TailOrder, true, true>(lds, g, S, E); }
    }
    GSYNC();
    if (PHMASK & (1u << 10)) {
    norm_rows<1, true, true, true, 1>(Fm, PART, nullptr, nullptr, MT, MT, XB, XB, nullptr, 1.0f, p.in[14], p.in[21], HB, lds, tid, gw, NGW, lane);
    }
    GSYNC();
    if (PHMASK & (1u << 11)) {
    { pg8::Gemm g{HB, W_MQ, MT, 512, DM}; pg8::StaticOrder S; S.init(MT, 512, G, bx, DM); pg8::EpiBf16 E{QM, 512};
      pg8::gemm_phase<pg8::EpiBf16, pg8::StaticOrder, true, true>(lds, g, S, E); }
    { pg8::Gemm g{MEMN, W_MKV, 1024, 1024, DM}; pg8::StaticOrder S; S.init(1024, 1024, G, (bx + G - 136) % G, DM); pg8::EpiMemKV E{out + O_PMK, out + O_PMV, MK, MV};
      pg8::gemm_phase<pg8::EpiMemKV, pg8::StaticOrder, true, true>(lds, g, S, E); }
    { const bool tail = (G == 256 && bx >= 152); const int gw2 = tail ? (bx - 152) * 8 + wave : gw, ngw2 = tail ? 104 * 8 : NGW;
      if (tail || G != 256) {
        wt_matrix(p.in[32], DFF, DM, W_D, 0, 0, scr, gw2, ngw2, lane);
        wt_matrix(p.in[31], DM, DFF, W_GU, 2, 0, scr, gw2, ngw2, lane); } }
    }
    GSYNC();
    if (PHMASK & (1u << 12)) {
    for (int u = bx; u < 256; u += G) mem_attn_prompt_unit(u, QM, MK, MV, OM, lds, tid, wave, lane);
    for (int u = bx; u < 512; u += G) mem_attn_sample_unit(u, QM, p.in[6], p.in[7], OM, lds, tid, wave, lane);
    }
    GSYNC();
    if (PHMASK & (1u << 13)) {
    { pg8::Gemm g{OM, W_MO, MT, DM, 512}; pg8::StaticOrder S; S.init(MT, DM, G, bx, 512); pg8::EpiF32 E{Fm, DM, nullptr};
      pg8::gemm_phase<pg8::EpiF32, pg8::StaticOrder, true, true>(lds, g, S, E); }
    { const bool tail = (G == 256 && bx >= 32); const int gw2 = tail ? (bx - 32) * 8 + wave : gw, ngw2 = tail ? 224 * 8 : NGW;
      if (tail || G != 256) wt_matrix(p.in[30], DM, DFF, W_GU, 1, 0, scr, gw2, ngw2, lane); }
    }
    GSYNC();
    if (PHMASK & (1u << 14)) {
    norm_rows<1, true, true, false, 1>(Fm, nullptr, nullptr, nullptr, MT, MT, XB, XB, nullptr, 1.0f, p.in[22], p.in[28], HB, lds, tid, gw, NGW, lane);
    }
    GSYNC();
    if (PHMASK & (1u << 15)) {
    { pg8::Gemm g{HB, W_GU, MT, 2 * DFF, DM}; pg8::StaticOrder S; S.init(MT, 2 * DFF, G, bx, DM); pg8::EpiSwiglu E{ACT, DFF};
      pg8::gemm_phase<pg8::EpiSwiglu, pg8::StaticOrder, true, true>(lds, g, S, E); }
    if (G == 256) { if (bx >= 176) win_cache_copy(p.in[3], p.in[4], out, (bx - 176) * 512 + tid, 80 * 512); }
    else win_cache_copy(p.in[3], p.in[4], out, gtid, gthreads);
    }
    GSYNC();
    if (PHMASK & (1u << 16)) {
    { pg8::Gemm g{ACT, W_D, MT, DM, DFF}; pg8::TailOrder S; S.init(DM, G, bx, DFF); pg8::EpiF32 E{Fm, DM, PART};
      pg8::gemm_phase<pg8::EpiF32, pg8::TailOrder, true, true>(lds, g, S, E); }
    }
    GSYNC();
    if (PHMASK & (1u << 17)) {
    norm_rows<1, true, false, true, 2>(Fm, PART, nullptr, nullptr, MT, MT, XB, nullptr, X, 0.5f, p.in[29], nullptr, nullptr, lds, tid, gw, NGW, lane);
    }
    if (G == 0x7ffffff0) grid.sync();
}

extern "C" void kernel_launch(void* const* d_in, const int* in_sizes, int n_in, void* d_out, int out_size, void* d_ws, size_t ws_size, hipStream_t stream) {
    static int grid = 0;
    if (grid == 0) {
        if (n_in != 33 || ws_size < WS_END2) { fprintf(stderr, "kernel_launch: unexpected n_in %d / ws %zu\n", n_in, ws_size); grid = -1; return; }
        int dev = 0, cus = 0, per_cu = 0;
        hipGetDevice(&dev); hipDeviceGetAttribute(&cus, hipDeviceAttributeMultiprocessorCount, dev);
        hipFuncSetAttribute((const void*)mega_fwd, hipFuncAttributeMaxDynamicSharedMemorySize, LDS_BYTES);
        hipOccupancyMaxActiveBlocksPerMultiprocessor(&per_cu, (const void*)mega_fwd, 512, LDS_BYTES);
        if (per_cu < 1) { fprintf(stderr, "kernel_launch: occupancy query says %d blocks/CU\n", per_cu); per_cu = 1; }
        (void)hipGetLastError();
        grid = cus * 1;
    }
    if (grid < 0) return;
    if (hipMemsetAsync((char*)d_ws + WS_BAR, 0, 16384, stream) != hipSuccess) { fprintf(stderr, "memset failed\n"); return; }
    Params p{};
    for (int i = 0; i < 33; ++i) p.in[i] = (const float*)d_in[i];
    p.out = (float*)d_out; p.ws = (unsigned char*)d_ws;
    void* args[] = {&p};
    hipError_t e = hipLaunchCooperativeKernel((const void*)mega_fwd, dim3(grid), dim3(512), args, LDS_BYTES, stream);
    if (e != hipSuccess) fprintf(stderr, "cooperative launch failed: %s (grid %d)\n", hipGetErrorString(e), grid);
}
```
